# Optimizing an MI355X kernel written in HIP

```python
import jax
import jax.numpy as jnp
from jax import lax
import numpy as np

D_MODEL = 2048
BATCH = 1
SEQ = 8192
DEPTH = 1
DEC_BATCH = 8
DEC_SEQ = 4096
PAST_LEN = 128

GRID_W = 64
NA_HEADS = 8
NA_HEAD_DIM = 128
NA_WIDTH = NA_HEADS * NA_HEAD_DIM
NA_KH_MAX = 8
NA_KW = 16
NA_QB = 16
NA_KB = 32
NA_NCB = GRID_W // NA_QB
ML_HEADS = 4
ML_HEAD_DIM = 256
ML_WIDTH = ML_HEADS * ML_HEAD_DIM
ML_CHUNK = 128
ML_CONV = 5
D_FF = 5632
N_GATE = 4 * ML_HEADS
SPLIT_SIZES = (NA_WIDTH, NA_WIDTH, NA_WIDTH, 2 * ML_WIDTH, ML_WIDTH, ML_WIDTH, N_GATE, D_MODEL, D_MODEL)
D_IN = sum(SPLIT_SIZES)
ALPHA = (2 * DEPTH) ** 0.25
BETA = (8 * DEPTH) ** -0.25
LN_EPS = 1e-5

kernel_name = "hybrid_natten_mlstm_macaron_deepnorm_encoder"


def _split_points():
    return np.cumsum(np.array(SPLIT_SIZES))[:-1].tolist()


def _layernorm(x, g, b):
    xf = x.astype(jnp.float32)
    mu = xf.mean(-1, keepdims=True)
    var = jnp.square(xf - mu).mean(-1, keepdims=True)
    return ((xf - mu) * lax.rsqrt(var + LN_EPS) * g + b).astype(x.dtype)


def _swiglu(x, w_gu, w_down):
    g, u = jnp.split(x @ w_gu, 2, axis=-1)
    return (jax.nn.silu(g) * u) @ w_down


def _na_col_tables():
    qc = np.arange(GRID_W).reshape(NA_NCB, NA_QB)
    kstart = np.clip(np.arange(NA_NCB) * NA_QB - NA_KW // 2, 0, GRID_W - NA_KB)
    kc = kstart[:, None] + np.arange(NA_KB)[None, :]
    ws = np.clip(qc - NA_KW // 2, 0, GRID_W - NA_KW)
    kcb = kc[:, None, :]
    valid = (kcb >= ws[:, :, None]) & (kcb < ws[:, :, None] + NA_KW)
    col_idx = np.clip(kcb - qc[:, :, None] + NA_KW - 1, 0, 2 * NA_KW - 2)
    return kc, col_idx, valid


def _neighbourhood_attention(q, k, v, rpb):
    B, N, _ = q.shape
    rows = N // GRID_W
    kh = min(NA_KH_MAX, rows)

    def to_grid(t):
        return t.reshape(B, rows, GRID_W, NA_HEADS, NA_HEAD_DIM).transpose(0, 3, 1, 2, 4)

    qg = to_grid(q) * (NA_HEAD_DIM ** -0.5)
    kg = to_grid(k)
    vg = to_grid(v)
    kc, col_idx, valid = _na_col_tables()
    kc_flat = jnp.asarray(kc.reshape(-1))
    bias_col = rpb[:, :, col_idx].astype(jnp.float32)
    valid_m = jnp.asarray(valid)[None, None, :, :, None, :]
    q_rows = qg.reshape(B, NA_HEADS, rows, NA_NCB, NA_QB, NA_HEAD_DIM).transpose(2, 0, 1, 3, 4, 5)

    def one_row(args):
        r, qr = args
        rs = jnp.clip(r - kh // 2, 0, rows - kh)
        kb = jnp.take(lax.dynamic_slice_in_dim(kg, rs, kh, axis=2), kc_flat, axis=3)
        vb = jnp.take(lax.dynamic_slice_in_dim(vg, rs, kh, axis=2), kc_flat, axis=3)
        kb = kb.reshape(B, NA_HEADS, kh, NA_NCB, NA_KB, NA_HEAD_DIM)
        vb = vb.reshape(B, NA_HEADS, kh, NA_NCB, NA_KB, NA_HEAD_DIM)
        s = jnp.einsum('bhcqd,bhackd->bhcqak', qr, kb).astype(jnp.float32)
        row_idx = rs + jnp.arange(kh) - r + (NA_KH_MAX - 1)
        bias = jnp.take(bias_col, row_idx, axis=1).transpose(0, 2, 3, 1, 4)
        s = jnp.where(valid_m, s + bias[None], -jnp.inf)
        p = jax.nn.softmax(s.reshape(B, NA_HEADS, NA_NCB, NA_QB, kh * NA_KB), axis=-1)
        p = p.reshape(B, NA_HEADS, NA_NCB, NA_QB, kh, NA_KB).astype(vb.dtype)
        return jnp.einsum('bhcqak,bhackd->bhcqd', p, vb)

    out = lax.map(one_row, (jnp.arange(rows), q_rows))
    return out.transpose(1, 0, 3, 4, 2, 5).reshape(B, N, NA_WIDTH)


def _to_chunks(t, nc):
    G, H = t.shape[:2]
    return jnp.moveaxis(t.reshape((G, H, nc, ML_CHUNK) + t.shape[3:]), 2, 0)


def _mlstm_chunkwise(q, k, v, log_i, log_f):
    G, H, N, d = q.shape
    nc = N // ML_CHUNK
    causal = jnp.tril(jnp.ones((ML_CHUNK, ML_CHUNK), dtype=bool))

    def step(carry, inp):
        C, n, m = carry
        qb, kb, vb, ib, fb = inp
        b = jnp.cumsum(fb, axis=-1)
        dmat = jnp.where(causal, b[..., :, None] - b[..., None, :] + ib[..., None, :], -jnp.inf)
        inter = b + m[..., None]
        mt = jnp.maximum(inter, dmat.max(-1))
        sc = jnp.einsum('ghtd,ghsd->ghts', qb, kb) * jnp.exp(dmat - mt[..., None])
        a_inter = jnp.exp(inter - mt)
        num = jnp.einsum('ghts,ghsd->ghtd', sc, vb) + a_inter[..., None] * jnp.einsum('ghtd,ghde->ghte', qb, C)
        den = sc.sum(-1) + a_inter * jnp.einsum('ghtd,ghd->ght', qb, n)
        h = num / jnp.maximum(jnp.abs(den), jnp.exp(-mt))[..., None]
        b_last = b[..., -1]
        g = b_last[..., None] - b + ib
        m_new = jnp.maximum(b_last + m, g.max(-1))
        wk = kb * jnp.exp(g - m_new[..., None])[..., None]
        decay = jnp.exp(b_last + m - m_new)
        C_new = decay[..., None, None] * C + jnp.einsum('ghsd,ghse->ghde', wk, vb)
        n_new = decay[..., None] * n + wk.sum(axis=2)
        return (C_new, n_new, m_new), h

    init = (jnp.zeros((G, H, d, d), jnp.float32), jnp.zeros((G, H, d), jnp.float32), jnp.zeros((G, H), jnp.float32))
    xs = (_to_chunks(q, nc), _to_chunks(k, nc), _to_chunks(v, nc), _to_chunks(log_i, nc), _to_chunks(log_f, nc))
    _, hs = lax.scan(step, init, xs)
    return jnp.moveaxis(hs, 0, 2).reshape(G, H, N, d)


def _mlstm_branch(qk_raw, v, o, gates, conv_w, conv_b, gate_b, norm_g):
    B, N, _ = v.shape
    pad = ML_CONV // 2
    qk = lax.conv_general_dilated(qk_raw, conv_w[:, None, :], window_strides=(1,), padding=[(pad, pad)],
                                  dimension_numbers=('NWC', 'WIO', 'NWC'),
                                  feature_group_count=2 * ML_WIDTH) + conv_b
    qk = jax.nn.silu(qk).astype(jnp.float32)
    q, k = jnp.split(qk, 2, axis=-1)

    def heads(t):
        return t.reshape(B, N, ML_HEADS, ML_HEAD_DIM).transpose(0, 2, 1, 3)

    q = heads(q)
    k = heads(k) * (ML_HEAD_DIM ** -0.5)
    vh = heads(v.astype(jnp.float32))
    gt = (gates.astype(jnp.float32) + gate_b.astype(jnp.float32)).transpose(0, 2, 1)
    i_f, i_b, f_f, f_b = jnp.split(gt, 4, axis=1)
    flip = lambda t: jnp.flip(t, axis=2)
    qq = jnp.concatenate([q, flip(q)], axis=0)
    kk = jnp.concatenate([k, flip(k)], axis=0)
    vv = jnp.concatenate([vh, flip(vh)], axis=0)
    li = jnp.concatenate([i_f, flip(i_b)], axis=0)
    lf = jax.nn.log_sigmoid(jnp.concatenate([f_f, flip(f_b)], axis=0))
    h = _mlstm_chunkwise(qq, kk, vv, li, lf)
    h = h[:B] + flip(h[B:])
    mu = h.mean(-1, keepdims=True)
    var = jnp.square(h - mu).mean(-1, keepdims=True)
    h = (h - mu) * lax.rsqrt(var + LN_EPS) * norm_g.astype(jnp.float32).reshape(ML_HEADS, ML_HEAD_DIM)[None, :, None, :]
    h = h.transpose(0, 2, 1, 3).reshape(B, N, ML_WIDTH)
    return (h * jax.nn.sigmoid(o.astype(jnp.float32))).astype(v.dtype)


def _mixer(x, w_in, rpb, conv_w, conv_b, gate_b, ml_norm_g, w_pa, w_pm, w_out):
    z = x @ w_in
    q_a, k_a, v_a, qk_m, v_m, o_m, gates, g_a, g_m = jnp.split(z, _split_points(), axis=-1)
    y_a = _neighbourhood_attention(q_a, k_a, v_a, rpb)
    y_m = _mlstm_branch(qk_m, v_m, o_m, gates, conv_w, conv_b, gate_b, ml_norm_g)
    merged = jax.nn.sigmoid(g_a) * (y_a @ w_pa) + jax.nn.sigmoid(g_m) * (y_m @ w_pm)
    return merged @ w_out


def _encoder(x, params):
    (ffa_w_gu, ffa_w_down, norm_a_g, norm_a_b, mix_w_in, na_rpb, ml_conv_w, ml_conv_b, ml_gate_b,
     ml_norm_g, mix_w_pa, mix_w_pm, mix_w_out, norm_m_g, norm_m_b, ffb_w_gu, ffb_w_down,
     norm_b_g, norm_b_b) = params
    for l in range(DEPTH):
        x = _layernorm(ALPHA * x + 0.5 * _swiglu(x, ffa_w_gu[l], ffa_w_down[l]), norm_a_g[l], norm_a_b[l])
        mix = _mixer(x, mix_w_in[l], na_rpb[l], ml_conv_w[l], ml_conv_b[l], ml_gate_b[l], ml_norm_g[l],
                     mix_w_pa[l], mix_w_pm[l], mix_w_out[l])
        x = _layernorm(ALPHA * x + mix, norm_m_g[l], norm_m_b[l])
        x = _layernorm(ALPHA * x + 0.5 * _swiglu(x, ffb_w_gu[l], ffb_w_down[l]), norm_b_g[l], norm_b_b[l])
    return x


def setup_inputs(seed: int = 0) -> dict:
    key = jax.random.key(seed)
    ks = jax.random.split(key, 24)
    f32 = jnp.float32

    def nrm(k, shape, scale):
        return jax.random.normal(k, shape, f32) * scale

    i_bias = nrm(ks[10], (DEPTH, 2 * ML_HEADS), 0.1)
    f_bias = jnp.tile(jnp.linspace(3.0, 6.0, ML_HEADS, dtype=f32), (DEPTH, 2)) + nrm(ks[11], (DEPTH, 2 * ML_HEADS), 0.01)
    return {
        "x_prompt": nrm(ks[0], (BATCH, SEQ, D_MODEL), 1.0),
        "x_sample": nrm(ks[1], (DEC_BATCH, DEC_SEQ, D_MODEL), 1.0),
        "ffa_w_gu": nrm(ks[2], (DEPTH, D_MODEL, 2 * D_FF), D_MODEL ** -0.5),
        "ffa_w_down": nrm(ks[3], (DEPTH, D_FF, D_MODEL), BETA * D_FF ** -0.5),
        "norm_a_g": 1.0 + nrm(ks[4], (DEPTH, D_MODEL), 0.02),
        "norm_a_b": nrm(ks[5], (DEPTH, D_MODEL), 0.02),
        "mix_w_in": nrm(ks[6], (DEPTH, D_MODEL, D_IN), D_MODEL ** -0.5),
        "na_rpb": nrm(ks[7], (DEPTH, NA_HEADS, 2 * NA_KH_MAX - 1, 2 * NA_KW - 1), 0.02),
        "ml_conv_w": nrm(ks[8], (DEPTH, ML_CONV, 2 * ML_WIDTH), ML_CONV ** -0.5),
        "ml_conv_b": nrm(ks[9], (DEPTH, 2 * ML_WIDTH), 0.02),
        "ml_gate_b": jnp.concatenate([i_bias, f_bias], axis=-1),
        "ml_norm_g": 1.0 + nrm(ks[12], (DEPTH, ML_WIDTH), 0.02),
        "mix_w_pa": nrm(ks[13], (DEPTH, NA_WIDTH, D_MODEL), NA_WIDTH ** -0.5),
        "mix_w_pm": nrm(ks[14], (DEPTH, ML_WIDTH, D_MODEL), ML_WIDTH ** -0.5),
        "mix_w_out": nrm(ks[15], (DEPTH, D_MODEL, D_MODEL), BETA * D_MODEL ** -0.5),
        "norm_m_g": 1.0 + nrm(ks[16], (DEPTH, D_MODEL), 0.02),
        "norm_m_b": nrm(ks[17], (DEPTH, D_MODEL), 0.02),
        "ffb_w_gu": nrm(ks[18], (DEPTH, D_MODEL, 2 * D_FF), D_MODEL ** -0.5),
        "ffb_w_down": nrm(ks[19], (DEPTH, D_FF, D_MODEL), BETA * D_FF ** -0.5),
        "norm_b_g": 1.0 + nrm(ks[20], (DEPTH, D_MODEL), 0.02),
        "norm_b_b": nrm(ks[21], (DEPTH, D_MODEL), 0.02),
    }


def reference(x_prompt, x_sample, ffa_w_gu, ffa_w_down, norm_a_g, norm_a_b, mix_w_in, na_rpb,
              ml_conv_w, ml_conv_b, ml_gate_b, ml_norm_g, mix_w_pa, mix_w_pm, mix_w_out,
              norm_m_g, norm_m_b, ffb_w_gu, ffb_w_down, norm_b_g, norm_b_b):
    params = (ffa_w_gu, ffa_w_down, norm_a_g, norm_a_b, mix_w_in, na_rpb, ml_conv_w, ml_conv_b,
              ml_gate_b, ml_norm_g, mix_w_pa, mix_w_pm, mix_w_out, norm_m_g, norm_m_b,
              ffb_w_gu, ffb_w_down, norm_b_g, norm_b_b)
    y_prompt = _encoder(x_prompt, params)
    y_sample = _encoder(x_sample, params)
    return (y_prompt, y_sample)
```

```cpp
#include <hip/hip_runtime.h>
#include <hip/hip_cooperative_groups.h>
#include <cstdio>
namespace cg = cooperative_groups;

#define LAS __attribute__((address_space(3)))
typedef unsigned short bf16_t;
typedef short bf16x8 __attribute__((ext_vector_type(8)));
typedef float f32x4 __attribute__((ext_vector_type(4)));
typedef unsigned u32x4 __attribute__((ext_vector_type(4)));
typedef unsigned u32x2 __attribute__((ext_vector_type(2)));

constexpr int T_ALL = 40960, TH = T_ALL, DM = 2048, DFF = 5632;
constexpr int NIN_PAD = 11520;
constexpr float ALPHA = 1.189207115002721f;
constexpr float LN_EPS = 1e-5f;
constexpr int LDS_BYTES = 163840;

constexpr size_t SZ_WGU = (size_t)2 * DFF * DM * 2, SZ_WDN = (size_t)DM * DFF * 2, SZ_WIN = (size_t)NIN_PAD * DM * 2;
constexpr size_t SZ_WPA = (size_t)DM * 1024 * 2, SZ_WOUT = (size_t)DM * DM * 2;
constexpr size_t OFF_WGU_A = 0, OFF_WDN_A = OFF_WGU_A + SZ_WGU, OFF_WIN = OFF_WDN_A + SZ_WDN, OFF_WPA = OFF_WIN + SZ_WIN,
                 OFF_WPM = OFF_WPA + SZ_WPA, OFF_WOUT = OFF_WPM + SZ_WPA, OFF_WGU_B = OFF_WGU_A, OFF_WDN_B = OFF_WDN_A,
                 OFF_XB = OFF_WOUT + SZ_WOUT, OFF_BIG = OFF_XB + (size_t)T_ALL * DM * 2;
constexpr size_t OFF_H = OFF_BIG;
constexpr size_t SZ_T2K = (size_t)T_ALL * 2048 * 2;
constexpr size_t OFF_ZNA = OFF_BIG;
constexpr size_t OFF_VTN = OFF_ZNA + SZ_T2K;
constexpr size_t OFF_ZQK = OFF_VTN + SZ_T2K / 2;
constexpr size_t OFF_QK = OFF_ZQK + SZ_T2K;
constexpr size_t OFF_VO = OFF_QK + SZ_T2K;
constexpr size_t OFF_G = OFF_QK;
constexpr size_t OFF_GATES = OFF_VO + SZ_T2K, SZ_GATES = (size_t)T_ALL * 16 * 4;
constexpr size_t OFF_HF = OFF_ZQK + SZ_T2K / 2, OFF_HB = OFF_XB;
constexpr size_t OFF_CTR = OFF_GATES + SZ_GATES;
constexpr size_t OFF_STATS_A = OFF_CTR + 1024, OFF_STATS_M = OFF_STATS_A + (size_t)T_ALL * 8;
constexpr size_t OFF_BAR = OFF_STATS_M + (size_t)T_ALL * 8;
constexpr size_t WS_END = OFF_BAR + 16384;
static_assert(OFF_H + (size_t)T_ALL * DFF * 2 <= (size_t)1 << 30, "H fits");
static_assert(WS_END <= (size_t)1 << 30, "mixer fits");

struct Params {
    const float* in[21];
    float* out;
    unsigned char* ws;
};

__device__ __forceinline__ float bf2f(unsigned short b) { return __uint_as_float(((unsigned)b) << 16); }
__device__ __forceinline__ float bflo(unsigned w) { return __uint_as_float(w << 16); }
__device__ __forceinline__ float bfhi(unsigned w) { return __uint_as_float(w & 0xffff0000u); }
__device__ __forceinline__ unsigned short f2bf(float f) { unsigned u = __float_as_uint(f); u += 0x7FFFu + ((u >> 16) & 1u); return (unsigned short)(u >> 16); }
__device__ __forceinline__ unsigned pk2(float lo, float hi) { unsigned r; asm("v_cvt_pk_bf16_f32 %0, %1, %2" : "=v"(r) : "v"(lo), "v"(hi)); return r; }
typedef _Float16 h16x2 __attribute__((ext_vector_type(2)));
__device__ __forceinline__ float hlo(unsigned w) { return (float)__builtin_bit_cast(h16x2, w)[0]; }
__device__ __forceinline__ float hhi(unsigned w) { return (float)__builtin_bit_cast(h16x2, w)[1]; }
__device__ __forceinline__ unsigned pkh(float lo, float hi) { h16x2 r; r[0] = (_Float16)lo; r[1] = (_Float16)hi; return __builtin_bit_cast(unsigned, r); }
__device__ __forceinline__ float sigmoidf_(float x) { return __builtin_amdgcn_rcpf(1.0f + __builtin_amdgcn_exp2f(-1.4426950408889634f * x)); }
__device__ __forceinline__ int otid() { int t = threadIdx.x; asm volatile("" : "+v"(t)); return t; }
__device__ __forceinline__ int obid() { int b = blockIdx.x; asm volatile("" : "+s"(b)); return b; }

namespace pg8 {
constexpr int BM = 256, BK = 64, HALF = 128, HTB = HALF * BK * 2, NXCD = 8, WGM = 8;
__host__ __device__ __forceinline__ int lds_byte(int r, int c) { const int st = (r >> 4) * 2 + (c >> 5), rr = r & 15, cc = c & 31, ob = rr * 64 + cc * 2; return st * 1024 + (ob ^ (((ob >> 9) & 1) << 5)); }
__host__ __device__ __forceinline__ void stage_rc(int b, int& R, int& C) { const int st = b / 1024, sb = b % 1024, swz = sb ^ (((sb >> 9) & 1) << 5); R = (st >> 1) * 16 + swz / 64; C = (st & 1) * 32 + (swz % 64) / 2; }
__host__ __device__ __forceinline__ int perm32(int rho) { const int n = rho >> 4, i = rho & 15; return 8 * (i >> 2) + 4 * n + (i & 3); }
struct Unit { int pm, pn; };
struct Gemm { const bf16_t* A; const bf16_t* Bt; int M, N, K; };
struct StaticOrder {
    int nM, nN, nwg, G, c;
    __device__ void init(int M, int N, int G_, int c_) { nM = M / BM; nN = N / BM; nwg = nM * nN; G = G_; c = c_; }
    __device__ bool next(int i, Unit& u) const {
        const long L = (long)i * G + c; if (L >= nwg) return false;
        int wgid = (int)L; { const int q = nwg / NXCD, r = nwg % NXCD, xcd = wgid % NXCD, off = wgid / NXCD; wgid = (xcd < r ? xcd * (q + 1) : r * (q + 1) + (xcd - r) * q) + off; }
        const int nig = WGM * nN, gid = wgid / nig, fm = gid * WGM, gsz = (nM - fm) < WGM ? (nM - fm) : WGM;
        u.pm = fm + ((wgid % nig) % gsz); u.pn = (wgid % nig) / gsz; return true;
    }
};

template <class Epi>
__device__ __forceinline__ void gemm_phase(LAS unsigned char* lds, const Gemm g, const StaticOrder& S, const Epi& E) {
    const int tid = otid(), wid = __builtin_amdgcn_readfirstlane(tid >> 6), lane = tid & 63, wr = wid >> 2, wc = wid & 3, fr = lane & 15, fq = lane >> 4;
    const int K = g.K, nt = K / BK;
    unsigned voffA[2], voffB[2];
#pragma unroll
    for (int i = 0; i < 2; ++i) { int R, C; stage_rc(tid * 16 + i * 8192, R, C); const int Rb = Epi::PERM ? ((R & ~31) + perm32(R & 31)) : R;
        voffA[i] = (unsigned)(R * K + C) * 2u; voffB[i] = (unsigned)(Rb * K + C) * 2u; }
    const size_t kstep = (size_t)(BK * 2);
    const size_t hstep = (size_t)HALF * K * 2;
    const size_t tstep = 2 * hstep;
    const unsigned ldsw = (unsigned)wid * 1024u;
    const int aoff = lds_byte(wr * 64 + fr, fq * 8), boff = lds_byte(wc * 32 + fr, fq * 8);
#define PG8_SA(b, h) (((b) * 2 + (h)) * HTB)
#define PG8_SB(b, h) ((4 + (b) * 2 + (h)) * HTB)
#define PG8_STAGE(bufoff, gbase, voff) do { _Pragma("unroll") for (int _i = 0; _i < 2; ++_i) \
        __builtin_amdgcn_global_load_lds((const unsigned*)((const char*)(gbase) + (voff)[_i]), (LAS unsigned*)(lds + (bufoff) + ldsw + _i * 8192), 16, 0, 0); } while (0)
#define PG8_LDA(dst, b, h) do { _Pragma("unroll") for (int m = 0; m < 4; ++m) _Pragma("unroll") for (int k = 0; k < 2; ++k) dst[m][k] = *(const LAS bf16x8*)(lds + PG8_SA(b, h) + aoff + m * 2048 + k * 1024); } while (0)
#define PG8_LDB(dst, b, h) do { _Pragma("unroll") for (int n = 0; n < 2; ++n) _Pragma("unroll") for (int k = 0; k < 2; ++k) dst[n][k] = *(const LAS bf16x8*)(lds + PG8_SB(b, h) + boff + n * 2048 + k * 1024); } while (0)
#define PG8_MMA(ai, bj, At, Bt) do { __builtin_amdgcn_s_setprio(1); _Pragma("unroll") for (int m = 0; m < 4; ++m) _Pragma("unroll") for (int n = 0; n < 2; ++n) _Pragma("unroll") for (int k = 0; k < 2; ++k) \
        acc[ai][bj][m][n] = __builtin_amdgcn_mfma_f32_16x16x32_bf16(Bt[n][k], At[m][k], acc[ai][bj][m][n], 0, 0, 0); __builtin_amdgcn_s_setprio(0); } while (0)
#define PG8_WAIT_V(n) asm volatile("s_waitcnt vmcnt(" #n ")" ::: "memory")
#define PG8_WAIT_L(n) asm volatile("s_waitcnt lgkmcnt(" #n ")" ::: "memory")
#define PG8_BAR __builtin_amdgcn_s_barrier()
#define PG8_SCHED __builtin_amdgcn_sched_barrier(0)
    Unit cur, nxt; int ui = 0;
    if (!S.next(0, cur)) return;
    f32x4 acc[2][2][4][2];
#pragma unroll
    for (int a = 0; a < 2; ++a)
#pragma unroll
        for (int b = 0; b < 2; ++b)
#pragma unroll
            for (int m = 0; m < 4; ++m)
#pragma unroll
                for (int n = 0; n < 2; ++n) acc[a][b][m][n] = (f32x4){0.f, 0.f, 0.f, 0.f};
    bf16x8 At[4][2], B0[2][2], B1[2][2];
    const char* cA = (const char*)g.A + (size_t)cur.pm * tstep; const char* cB = (const char*)g.Bt + (size_t)cur.pn * tstep;
    PG8_STAGE(PG8_SB(0, 0), cB, voffB); PG8_STAGE(PG8_SA(0, 0), cA, voffA); PG8_STAGE(PG8_SB(0, 1), cB + hstep, voffB); PG8_STAGE(PG8_SA(0, 1), cA + hstep, voffA);
    if (wr == 1) PG8_BAR;
    PG8_WAIT_V(4); PG8_BAR;
    PG8_STAGE(PG8_SB(1, 0), cB + kstep, voffB); PG8_STAGE(PG8_SA(1, 0), cA + kstep, voffA); PG8_STAGE(PG8_SB(1, 1), cB + hstep + kstep, voffB);
    PG8_WAIT_V(6); PG8_BAR;
    for (;;) {
        const bool has_next = S.next(ui + 1, nxt);
        const char* nA = has_next ? (const char*)g.A + (size_t)nxt.pm * tstep : cA; const char* nB = has_next ? (const char*)g.Bt + (size_t)nxt.pn * tstep : cB;
        for (int t = 0; t < nt; t += 2) {
            const bool last = (t == nt - 2);
            const char* a1 = cA + (size_t)(t + 1) * kstep;
            const char* a2 = last ? nA : cA + (size_t)(t + 2) * kstep; const char* b2 = last ? nB : cB + (size_t)(t + 2) * kstep;
            const char* a3 = a2 + kstep; const char* b3 = b2 + kstep;
            PG8_LDB(B0, 0, 0); PG8_SCHED; PG8_LDA(At, 0, 0); PG8_STAGE(PG8_SA(1, 1), a1 + hstep, voffA);
            PG8_WAIT_L(8); PG8_BAR; PG8_WAIT_L(0); PG8_MMA(0, 0, At, B0); PG8_BAR; PG8_SCHED;
            PG8_LDB(B1, 0, 1); PG8_STAGE(PG8_SB(0, 0), b2, voffB);
            PG8_BAR; PG8_WAIT_L(0); PG8_MMA(0, 1, At, B1); PG8_BAR;
            PG8_LDA(At, 0, 1); PG8_STAGE(PG8_SA(0, 0), a2, voffA);
            PG8_BAR; PG8_WAIT_L(0); PG8_MMA(1, 0, At, B0); PG8_BAR; PG8_SCHED;
            PG8_STAGE(PG8_SB(0, 1), b2 + hstep, voffB);
            PG8_WAIT_V(6); PG8_BAR; PG8_MMA(1, 1, At, B1); PG8_BAR;
            PG8_LDB(B0, 1, 0); PG8_SCHED; PG8_LDA(At, 1, 0); PG8_STAGE(PG8_SA(0, 1), a2 + hstep, voffA);
            PG8_WAIT_L(8); PG8_BAR; PG8_WAIT_L(0); PG8_MMA(0, 0, At, B0); PG8_BAR; PG8_SCHED;
            PG8_LDB(B1, 1, 1); PG8_STAGE(PG8_SB(1, 0), b3, voffB);
            PG8_BAR; PG8_WAIT_L(0); PG8_MMA(0, 1, At, B1); PG8_BAR;
            PG8_LDA(At, 1, 1); PG8_STAGE(PG8_SA(1, 0), a3, voffA);
            PG8_BAR; PG8_WAIT_L(0); PG8_MMA(1, 0, At, B0); PG8_BAR; PG8_SCHED;
            PG8_STAGE(PG8_SB(1, 1), b3 + hstep, voffB);
            PG8_WAIT_V(6); PG8_BAR; PG8_MMA(1, 1, At, B1); PG8_BAR;
        }
        E(acc, cur, wr, wc, fr, fq);
        if (!has_next) break;
#pragma unroll
        for (int a = 0; a < 2; ++a)
#pragma unroll
            for (int b = 0; b < 2; ++b)
#pragma unroll
                for (int m = 0; m < 4; ++m)
#pragma unroll
                    for (int n = 0; n < 2; ++n) acc[a][b][m][n] = (f32x4){0.f, 0.f, 0.f, 0.f};
        cur = nxt; cA = nA; cB = nB; ++ui;
    }
    PG8_WAIT_V(0);
    if (wr == 0) PG8_BAR;
    PG8_BAR;
#undef PG8_SA
#undef PG8_SB
#undef PG8_STAGE
#undef PG8_LDA
#undef PG8_LDB
#undef PG8_MMA
#undef PG8_WAIT_V
#undef PG8_WAIT_L
#undef PG8_BAR
#undef PG8_SCHED
}
}
using pg8::Unit;
typedef f32x4 Acc[2][2][4][2];

struct EpiSwiglu {
    static constexpr bool PERM = true;
    bf16_t* H;
    __device__ __forceinline__ void operator()(const Acc& acc, const Unit& u, int wr, int wc, int fr, int fq) const {
        const int row0 = u.pm * 256 + wr * 64 + fr, col0 = u.pn * 128 + wc * 32 + 8 * fq;
#pragma unroll
        for (int ai = 0; ai < 2; ++ai)
#pragma unroll
            for (int m = 0; m < 4; ++m) {
                float h[8];
#pragma unroll
                for (int n = 0; n < 2; ++n)
#pragma unroll
                    for (int j = 0; j < 4; ++j) { const float gv = acc[ai][0][m][n][j], uv = acc[ai][1][m][n][j]; h[n * 4 + j] = gv * sigmoidf_(gv) * uv; }
                u32x4 w; w.x = pk2(h[0], h[1]); w.y = pk2(h[2], h[3]); w.z = pk2(h[4], h[5]); w.w = pk2(h[6], h[7]);
                *(u32x4*)(H + (size_t)(row0 + ai * 128 + m * 16) * DFF + col0) = w;
            }
    }
};
struct EpiResid {
    static constexpr bool PERM = true;
    const bf16_t* xres; bf16_t* out; float scale; const float* stats; const float* lg; const float* lb; int x_bf16;
    __device__ __forceinline__ void operator()(const Acc& acc, const Unit& u, int wr, int wc, int fr, int fq) const {
        const int row0 = u.pm * 256 + wr * 64 + fr, col0 = u.pn * 256 + wc * 32 + 8 * fq;
        const bf16_t* __restrict__ xr = xres; bf16_t* __restrict__ op = out;
        f32x4 gv[2][2], bv[2][2];
        if (stats) {
#pragma unroll
            for (int bj = 0; bj < 2; ++bj)
#pragma unroll
                for (int n = 0; n < 2; ++n) { gv[bj][n] = *(const f32x4*)(lg + col0 + bj * 128 + n * 4); bv[bj][n] = *(const f32x4*)(lb + col0 + bj * 128 + n * 4); } }
        u32x4 xv[2][2]; float mu[2], rs[2];
#pragma unroll
        for (int bj = 0; bj < 2; ++bj) xv[0][bj] = *(const u32x4*)(xr + (size_t)row0 * DM + col0 + bj * 128);
        mu[0] = 0.f; rs[0] = 1.f;
        if (stats) { mu[0] = stats[(size_t)row0 * 2]; rs[0] = stats[(size_t)row0 * 2 + 1]; }
#pragma unroll
        for (int gidx = 0; gidx < 8; ++gidx) {
            const int ai = gidx >> 2, m = gidx & 3;
            if (gidx + 1 < 8) { const int ai2 = (gidx + 1) >> 2, m2 = (gidx + 1) & 3; const size_t row2 = (size_t)(row0 + ai2 * 128 + m2 * 16);
#pragma unroll
                for (int bj = 0; bj < 2; ++bj) xv[(gidx + 1) & 1][bj] = *(const u32x4*)(xr + row2 * DM + col0 + bj * 128);
                mu[(gidx + 1) & 1] = 0.f; rs[(gidx + 1) & 1] = 1.f;
                if (stats) { mu[(gidx + 1) & 1] = stats[row2 * 2]; rs[(gidx + 1) & 1] = stats[row2 * 2 + 1]; } }
            const size_t rb = (size_t)(row0 + ai * 128 + m * 16) * DM + col0;
#pragma unroll
            for (int bj = 0; bj < 2; ++bj) { const u32x4 x4 = xv[gidx & 1][bj];
                f32x4 r0, r1;
                if (x_bf16) { r0 = (f32x4){bflo(x4.x), bfhi(x4.x), bflo(x4.y), bfhi(x4.y)}; r1 = (f32x4){bflo(x4.z), bfhi(x4.z), bflo(x4.w), bfhi(x4.w)}; }
                else { r0 = (f32x4){hlo(x4.x), hhi(x4.x), hlo(x4.y), hhi(x4.y)}; r1 = (f32x4){hlo(x4.z), hhi(x4.z), hlo(x4.w), hhi(x4.w)}; }
                if (stats) { r0 = (r0 - mu[gidx & 1]) * rs[gidx & 1] * gv[bj][0] + bv[bj][0]; r1 = (r1 - mu[gidx & 1]) * rs[gidx & 1] * gv[bj][1] + bv[bj][1]; }
                const f32x4 o0 = r0 * ALPHA + acc[ai][bj][m][0] * scale, o1 = r1 * ALPHA + acc[ai][bj][m][1] * scale;
                u32x4 w; w.x = pkh(o0[0], o0[1]); w.y = pkh(o0[2], o0[3]); w.z = pkh(o1[0], o1[1]); w.w = pkh(o1[2], o1[3]);
                *(u32x4*)(op + rb + bj * 128) = w; }
        }
    }
};
struct EpiInproj {
    static constexpr bool PERM = true;
    bf16_t *zna, *zqk, *vo, *g; bf16_t* vt; int gmode;
    __device__ __forceinline__ void operator()(const Acc& acc, const Unit& u, int wr, int wc, int fr, int fq) const {
        const int pn = u.pn; const int row0 = u.pm * 256 + wr * 64 + fr;
        bf16_t* base; int ld, cb; bool act;
        if (vt) { base = vt; ld = TH; cb = 256 * pn; act = false; }
        else if (gmode) { base = g; ld = 4096; cb = 256 * pn; act = true; }
        else if (pn < 8) { base = zna; ld = 2048; cb = 256 * pn; act = false; }
        else if (pn < 16) { base = zqk; ld = 2048; cb = 256 * (pn - 8); act = false; }
        else if (pn < 24) { base = vo; ld = 2048; cb = 256 * (pn - 16); act = pn >= 20; }
        else { base = g; ld = 4096; cb = 256 * (pn - 24); act = true; }
        const int col0 = cb + wc * 32 + 8 * fq;
#pragma unroll
        for (int ai = 0; ai < 2; ++ai)
#pragma unroll
            for (int m = 0; m < 4; ++m) { bf16_t* rowp = base + (size_t)(row0 + ai * 128 + m * 16) * ld + col0;
#pragma unroll
                for (int bj = 0; bj < 2; ++bj) { f32x4 v0 = acc[ai][bj][m][0], v1 = acc[ai][bj][m][1];
                    if (act) {
#pragma unroll
                        for (int j = 0; j < 4; ++j) { v0[j] = sigmoidf_(v0[j]); v1[j] = sigmoidf_(v1[j]); } }
                    u32x4 w; w.x = pk2(v0[0], v0[1]); w.y = pk2(v0[2], v0[3]); w.z = pk2(v1[0], v1[1]); w.w = pk2(v1[2], v1[3]);
                    *(u32x4*)(rowp + bj * 128) = w; } }
    }
};
struct EpiMerge {
    static constexpr bool PERM = true;
    const bf16_t* gate; bf16_t* merged; int accum;
    __device__ __forceinline__ void operator()(const Acc& acc, const Unit& u, int wr, int wc, int fr, int fq) const {
        const int row0 = u.pm * 256 + wr * 64 + fr, col0 = u.pn * 256 + wc * 32 + 8 * fq;
        const bf16_t* __restrict__ gp = gate; bf16_t* __restrict__ mg = merged;
        u32x4 gw[2][2], pw[2][2];
#pragma unroll
        for (int bj = 0; bj < 2; ++bj) { gw[0][bj] = *(const u32x4*)(gp + (size_t)row0 * 4096 + col0 + bj * 128);
            pw[0][bj] = accum ? *(const u32x4*)(mg + (size_t)row0 * 2048 + col0 + bj * 128) : (u32x4){0u, 0u, 0u, 0u}; }
#pragma unroll
        for (int gidx = 0; gidx < 8; ++gidx) {
            const int ai = gidx >> 2, m = gidx & 3;
            if (gidx + 1 < 8) { const int ai2 = (gidx + 1) >> 2, m2 = (gidx + 1) & 3; const size_t row2 = (size_t)(row0 + ai2 * 128 + m2 * 16);
#pragma unroll
                for (int bj = 0; bj < 2; ++bj) { gw[(gidx + 1) & 1][bj] = *(const u32x4*)(gp + row2 * 4096 + col0 + bj * 128);
                    pw[(gidx + 1) & 1][bj] = accum ? *(const u32x4*)(mg + row2 * 2048 + col0 + bj * 128) : (u32x4){0u, 0u, 0u, 0u}; } }
            const size_t row = (size_t)(row0 + ai * 128 + m * 16);
#pragma unroll
            for (int bj = 0; bj < 2; ++bj) { const u32x4 g4 = gw[gidx & 1][bj], p4 = pw[gidx & 1][bj];
                float o[8]; const f32x4 v0 = acc[ai][bj][m][0], v1 = acc[ai][bj][m][1];
                o[0] = bflo(g4.x) * v0[0] + bflo(p4.x); o[1] = bfhi(g4.x) * v0[1] + bfhi(p4.x); o[2] = bflo(g4.y) * v0[2] + bflo(p4.y); o[3] = bfhi(g4.y) * v0[3] + bfhi(p4.y);
                o[4] = bflo(g4.z) * v1[0] + bflo(p4.z); o[5] = bfhi(g4.z) * v1[1] + bfhi(p4.z); o[6] = bflo(g4.w) * v1[2] + bflo(p4.w); o[7] = bfhi(g4.w) * v1[3] + bfhi(p4.w);
                u32x4 w; w.x = pk2(o[0], o[1]); w.y = pk2(o[2], o[3]); w.z = pk2(o[4], o[5]); w.w = pk2(o[6], o[7]);
                *(u32x4*)(mg + row * 2048 + col0 + bj * 128) = w; }
        }
    }
};

template <class Epi>
__device__ __forceinline__ void run_gemm(unsigned char* shm, const bf16_t* A, const bf16_t* Bt, int M, int N, int K, const Epi& E, int crot = 0) {
    pg8::Gemm g; g.A = A; g.Bt = Bt; g.M = M; g.N = N; g.K = K;
    int c_ = obid() + crot; if (c_ >= (int)gridDim.x) c_ -= (int)gridDim.x;
    pg8::StaticOrder S; S.init(M, N, (int)gridDim.x, c_);
    pg8::gemm_phase<Epi>((LAS unsigned char*)shm, g, S, E);
}

template <int MODE>
__device__ __forceinline__ int wsrc(int r) {
    if (MODE == 0) return r;
    if (MODE == 1) { const int pn = r >> 8, bj = (r >> 7) & 1, i = r & 127; return bj * DFF + 128 * pn + i; }
    if (r < 2048) return r; if (r < 6144) return r + 1024; if (r < 10240) return r + 1040; if (r < 10256) return r - 10240 + 7168; if (r < 10496) return -1; return r - 10496 + 2048;
}
template <int MODE>
__device__ void convert_w(const float* W, int K, int N, bf16_t* Bt, int rows_out, unsigned char* shm, int bid, int nblk) {
    float* tile = (float*)shm;
    const int tid = otid(), nkt = K / 256, ntiles = (rows_out / 64) * nkt;
    const int nn = tid & 63, kk0 = tid >> 6;
    float pre[32];
#define CW_LOAD(tt) do { const int r0_ = ((tt) / nkt) * 64, k0_ = ((tt) % nkt) * 256; const int src_ = wsrc<MODE>(r0_ + nn); \
        const float* wp_ = W + (size_t)(k0_ + kk0) * N + (src_ < 0 ? 0 : src_); \
        _Pragma("unroll") for (int i = 0; i < 32; ++i) { const float v_ = wp_[(size_t)(8 * i) * N]; pre[i] = src_ < 0 ? 0.f : v_; } } while (0)
    int t = bid;
    if (t < ntiles) CW_LOAD(t);
    for (; t < ntiles; t += nblk) {
        const int r0 = (t / nkt) * 64, k0 = (t % nkt) * 256;
#pragma unroll
        for (int i = 0; i < 32; ++i) tile[(kk0 + 8 * i) * 65 + nn] = pre[i];
        __syncthreads();
        if (t + nblk < ntiles) CW_LOAD(t + nblk);
#pragma unroll
        for (int q = 0; q < 4; ++q) { const int id = tid + 512 * q, n2 = id >> 5, kc = (id & 31) * 8; float v[8];
#pragma unroll
            for (int j = 0; j < 8; ++j) v[j] = tile[(kc + j) * 65 + n2];
            u32x4 w; w.x = pk2(v[0], v[1]); w.y = pk2(v[2], v[3]); w.z = pk2(v[4], v[5]); w.w = pk2(v[6], v[7]);
            *(u32x4*)(Bt + (size_t)(r0 + n2) * K + k0 + kc) = w; }
        __syncthreads();
    }
#undef CW_LOAD
}

__device__ void convert_x(const float* x, bf16_t* xb, size_t n) {
    const size_t n8 = n / 8;
    for (size_t i = (size_t)obid() * 512 + otid(); i < n8; i += (size_t)gridDim.x * 512) {
        const f32x4 a = *(const f32x4*)(x + i * 8), b = *(const f32x4*)(x + i * 8 + 4);
        u32x4 w; w.x = pk2(a[0], a[1]); w.y = pk2(a[2], a[3]); w.z = pk2(b[0], b[1]); w.w = pk2(b[2], b[3]);
        *(u32x4*)(xb + i * 8) = w;
    }
}

__device__ __forceinline__ float wave_sum(float v) {
#pragma unroll
    for (int o = 32; o >= 1; o >>= 1) v += __shfl_xor(v, o);
    return v;
}
__device__ __forceinline__ float wave_max(float v) {
#pragma unroll
    for (int o = 32; o >= 1; o >>= 1) v = fmaxf(v, __shfl_xor(v, o));
    return v;
}

__device__ void ln_phase(const bf16_t* X, const float* g, const float* b, bf16_t* xb, float* fout, int rows, float* stats) {
    const int tid_ = otid(); const int lane = tid_ & 63, wv = obid() * 8 + (tid_ >> 6), nw = gridDim.x * 8;
    u32x4 nx[4];
    if (wv < rows) {
#pragma unroll
        for (int i = 0; i < 4; ++i) nx[i] = *(const u32x4*)(X + (size_t)wv * DM + i * 512 + lane * 8); }
    for (int row = wv; row < rows; row += nw) {
        f32x4 v[8]; float s = 0.f;
#pragma unroll
        for (int i = 0; i < 4; ++i) { const u32x4 x4 = nx[i];
            v[2 * i] = (f32x4){hlo(x4.x), hhi(x4.x), hlo(x4.y), hhi(x4.y)}; v[2 * i + 1] = (f32x4){hlo(x4.z), hhi(x4.z), hlo(x4.w), hhi(x4.w)};
            s += ((v[2 * i][0] + v[2 * i][1]) + (v[2 * i][2] + v[2 * i][3])) + ((v[2 * i + 1][0] + v[2 * i + 1][1]) + (v[2 * i + 1][2] + v[2 * i + 1][3])); }
        if (row + nw < rows) {
#pragma unroll
            for (int i = 0; i < 4; ++i) nx[i] = *(const u32x4*)(X + (size_t)(row + nw) * DM + i * 512 + lane * 8); }
        const float mu = wave_sum(s) * (1.0f / DM);
        float q = 0.f;
#pragma unroll
        for (int i = 0; i < 8; ++i) { v[i] = v[i] - mu; q += (v[i][0] * v[i][0] + v[i][1] * v[i][1]) + (v[i][2] * v[i][2] + v[i][3] * v[i][3]); }
        const float rstd = rsqrtf(wave_sum(q) * (1.0f / DM) + LN_EPS);
        if (stats && lane == 0) { stats[(size_t)row * 2] = mu; stats[(size_t)row * 2 + 1] = rstd; }
#pragma unroll
        for (int i = 0; i < 4; ++i) { const int c = i * 512 + lane * 8;
            const f32x4 g0 = *(const f32x4*)(g + c), g1 = *(const f32x4*)(g + c + 4), b0 = *(const f32x4*)(b + c), b1 = *(const f32x4*)(b + c + 4);
            const f32x4 y0 = v[2 * i] * rstd * g0 + b0, y1 = v[2 * i + 1] * rstd * g1 + b1;
            if (fout) { *(f32x4*)(fout + (size_t)row * DM + c) = y0; *(f32x4*)(fout + (size_t)row * DM + c + 4) = y1; }
            if (xb) { u32x4 w; w.x = pk2(y0[0], y0[1]); w.y = pk2(y0[2], y0[3]); w.z = pk2(y1[0], y1[1]); w.w = pk2(y1[2], y1[3]); *(u32x4*)(xb + (size_t)row * DM + c) = w; } }
    }
}

__device__ void conv_phase(const bf16_t* zqk, const float* cw, const float* cb, bf16_t* qk, int half) {
    const int total = (TH / 4) * 256;
    for (int idx = obid() * 512 + otid(); idx < total; idx += gridDim.x * 512) {
        const int t4 = (idx >> 8) * 4, c8 = (idx & 255) * 8;
        int s0, s1;
        if (half == 0) { if (t4 < 8192) { s0 = 0; s1 = 8192; } else { s0 = 8192 + ((t4 - 8192) >> 12) * 4096; s1 = s0 + 4096; } }
        else { s0 = (t4 >> 12) * 4096; s1 = s0 + 4096; }
        float w[5][8], bia[8];
#pragma unroll
        for (int j = 0; j < 5; ++j) { const f32x4 w0 = *(const f32x4*)(cw + j * 2048 + c8), w1 = *(const f32x4*)(cw + j * 2048 + c8 + 4);
            w[j][0] = w0[0]; w[j][1] = w0[1]; w[j][2] = w0[2]; w[j][3] = w0[3]; w[j][4] = w1[0]; w[j][5] = w1[1]; w[j][6] = w1[2]; w[j][7] = w1[3]; }
        { const f32x4 b0 = *(const f32x4*)(cb + c8), b1 = *(const f32x4*)(cb + c8 + 4);
          bia[0] = b0[0]; bia[1] = b0[1]; bia[2] = b0[2]; bia[3] = b0[3]; bia[4] = b1[0]; bia[5] = b1[1]; bia[6] = b1[2]; bia[7] = b1[3]; }
        u32x4 r[8];
#pragma unroll
        for (int i = 0; i < 8; ++i) { const int tt = t4 - 2 + i; r[i] = (tt >= s0 && tt < s1) ? *(const u32x4*)(zqk + (size_t)tt * 2048 + c8) : (u32x4){0u, 0u, 0u, 0u}; }
        const float sc = c8 >= 1024 ? 0.0625f : 1.0f;
#pragma unroll
        for (int o = 0; o < 4; ++o) { float a[8];
#pragma unroll
            for (int q = 0; q < 8; ++q) a[q] = bia[q];
#pragma unroll
            for (int j = 0; j < 5; ++j) { const u32x4 x = r[o + j];
                a[0] += w[j][0] * bflo(x.x); a[1] += w[j][1] * bfhi(x.x); a[2] += w[j][2] * bflo(x.y); a[3] += w[j][3] * bfhi(x.y);
                a[4] += w[j][4] * bflo(x.z); a[5] += w[j][5] * bfhi(x.z); a[6] += w[j][6] * bflo(x.w); a[7] += w[j][7] * bfhi(x.w); }
#pragma unroll
            for (int q = 0; q < 8; ++q) a[q] = a[q] * sigmoidf_(a[q]) * sc;
            u32x4 wv; wv.x = pk2(a[0], a[1]); wv.y = pk2(a[2], a[3]); wv.z = pk2(a[4], a[5]); wv.w = pk2(a[6], a[7]);
            *(u32x4*)(qk + (size_t)(t4 + o) * 2048 + c8) = wv; }
    }
}

__device__ void gates_phase(const bf16_t* xbh  , const bf16_t* wg  , float* gates  ) {
    const int tid = otid(), lane = tid & 63, fr = lane & 15, fq = lane >> 4;
    for (int item = obid() * 8 + (tid >> 6); item < TH / 16; item += gridDim.x * 8) {
        const bf16_t* ap = xbh + (size_t)(item * 16 + fr) * DM + fq * 8;
        const bf16_t* bp = wg + (size_t)fr * DM + fq * 8;
        f32x4 acc0 = (f32x4){0.f, 0.f, 0.f, 0.f}, acc1 = (f32x4){0.f, 0.f, 0.f, 0.f};
#pragma unroll 8
        for (int kk = 0; kk < 64; kk += 2) {
            acc0 = __builtin_amdgcn_mfma_f32_16x16x32_bf16(*(const bf16x8*)(ap + kk * 32), *(const bf16x8*)(bp + kk * 32), acc0, 0, 0, 0);
            acc1 = __builtin_amdgcn_mfma_f32_16x16x32_bf16(*(const bf16x8*)(ap + kk * 32 + 32), *(const bf16x8*)(bp + kk * 32 + 32), acc1, 0, 0, 0); }
#pragma unroll
        for (int j = 0; j < 4; ++j) gates[(size_t)(item * 16 + fq * 4 + j) * 16 + fr] = acc0[j] + acc1[j];
    }
}

__device__ void na_phase(const bf16_t* zna  , const bf16_t* vtn  , const float* rpb, bf16_t* ya, int half, unsigned* counter) {
    const int tid = otid(), lane = tid & 63, fr = lane & 15, fq = lane >> 4;
    constexpr int NPH = (TH / 64) * 4;
    int hq = 0;
    for (;;) {
        int item = -1;
        if (lane == 0) { while (hq < 8) { const int hh = (obid() + hq) & 7; const unsigned v = atomicAdd(counter + hh * 16, 1u); if (v < (unsigned)NPH) { item = hh * NPH + (int)v; break; } ++hq; } }
        item = __builtin_amdgcn_readfirstlane(item); hq = __builtin_amdgcn_readfirstlane(hq);
        if (item < 0) break;
        const int h = item / NPH, rem = item - h * NPH, cbk = rem & 3, rowidx = rem >> 2;
        int seqrow0, rows;
        if (half == 0) { if (rowidx < 128) { seqrow0 = 0; rows = 128; } else { seqrow0 = 128 + ((rowidx - 128) >> 6) * 64; rows = 64; } }
        else { seqrow0 = (rowidx >> 6) * 64; rows = 64; }
        const int r = rowidx - seqrow0;
        const int rs = min(max(r - 4, 0), rows - 8);
        const int kstart = min(max(cbk * 16 - 8, 0), 32);
        const int krow0 = seqrow0 + rs;
        bf16x8 qf[4];
        { const bf16_t* qp = zna + (size_t)(rowidx * 64 + cbk * 16 + fr) * 2048 + h * 128 + fq * 8;
#pragma unroll
          for (int kk = 0; kk < 4; ++kk) qf[kk] = *(const bf16x8*)(qp + kk * 32); }
        f32x4 s[16];
        const int jperm = 8 * (fr >> 2) + (fr & 3);
#pragma unroll
        for (int a = 0; a < 8; ++a)
#pragma unroll
            for (int u = 0; u < 2; ++u) {
                const bf16_t* kp = zna + (size_t)((krow0 + a) * 64 + kstart + jperm + 4 * u) * 2048 + 1024 + h * 128 + fq * 8;
                f32x4 acc = (f32x4){0.f, 0.f, 0.f, 0.f};
#pragma unroll
                for (int kk = 0; kk < 4; ++kk) acc = __builtin_amdgcn_mfma_f32_16x16x32_bf16(*(const bf16x8*)(kp + kk * 32), qf[kk], acc, 0, 0, 0);
                s[a * 2 + u] = acc;
            }
        const int c = cbk * 16 + fr, wsx = min(max(c - 8, 0), 48);
        const float* bp = rpb + (h * 15 + (rs - r + 7)) * 31;
        float mx = -INFINITY;
#pragma unroll
        for (int a = 0; a < 8; ++a)
#pragma unroll
            for (int u = 0; u < 2; ++u)
#pragma unroll
                for (int j = 0; j < 4; ++j) { const int kc = kstart + 8 * fq + 4 * u + j; const bool valid = (kc >= wsx) && (kc < wsx + 16);
                    const int ci = min(max(kc - c + 15, 0), 30);
                    const float v = valid ? s[a * 2 + u][j] * 0.08838834764831845f + bp[a * 31 + ci] : -INFINITY;
                    s[a * 2 + u][j] = v; mx = fmaxf(mx, v); }
        mx = fmaxf(mx, __shfl_xor(mx, 16)); mx = fmaxf(mx, __shfl_xor(mx, 32));
        float sm = 0.f;
#pragma unroll
        for (int t = 0; t < 16; ++t)
#pragma unroll
            for (int j = 0; j < 4; ++j) { const float e = __expf(s[t][j] - mx); s[t][j] = e; sm += e; }
        sm += __shfl_xor(sm, 16); sm += __shfl_xor(sm, 32);
        f32x4 o[8];
#pragma unroll
        for (int dt = 0; dt < 8; ++dt) o[dt] = (f32x4){0.f, 0.f, 0.f, 0.f};
        const bf16_t* vb = vtn + (size_t)(h * 128 + fr) * TH + (size_t)krow0 * 64 + kstart + fq * 8;
#pragma unroll
        for (int a = 0; a < 8; ++a) {
            const u32x4 pw = (u32x4){pk2(s[2 * a][0], s[2 * a][1]), pk2(s[2 * a][2], s[2 * a][3]), pk2(s[2 * a + 1][0], s[2 * a + 1][1]), pk2(s[2 * a + 1][2], s[2 * a + 1][3])};
            const bf16x8 pf = *(const bf16x8*)&pw;
#pragma unroll
            for (int dt = 0; dt < 8; ++dt) { const bf16x8 vf = *(const bf16x8*)(vb + (size_t)dt * 16 * TH + a * 64);
                o[dt] = __builtin_amdgcn_mfma_f32_16x16x32_bf16(vf, pf, o[dt], 0, 0, 0); }
        }
        const float inv = 1.0f / sm;
        bf16_t* op = ya + (size_t)(rowidx * 64 + cbk * 16 + fr) * 1024 + h * 128 + fq * 4;
#pragma unroll
        for (int dt = 0; dt < 8; ++dt) { u32x2 w; w.x = pk2(o[dt][0] * inv, o[dt][1] * inv); w.y = pk2(o[dt][2] * inv, o[dt][3] * inv); *(u32x2*)(op + dt * 16) = w; }
    }
}

constexpr int ML_QS = 0, ML_KS = 33792, ML_VT = 67584, ML_CT = 79104, ML_VEC = 121344;
constexpr int ML_EP = 80, ML_HSLD = 68, ML_HS = 124416, ML_SC = ML_HS + 64 * ML_HSLD * 4, ML_VTW = ML_SC + 64 * 72 * 2;
static_assert(ML_VTW + ML_EP * 72 * 2 <= LDS_BYTES - 16, "mLSTM LDS layout fits");
__device__ void mlstm_phase(const bf16_t* qk, const bf16_t* vo, const float* gates, const float* gate_b, bf16_t* hf, bf16_t* hb, unsigned char* shm) {
    bf16_t* Qs = (bf16_t*)(shm + ML_QS); bf16_t* Ks = (bf16_t*)(shm + ML_KS); bf16_t* VT = (bf16_t*)(shm + ML_VT); bf16_t* CT = (bf16_t*)(shm + ML_CT);
    float* HS = (float*)(shm + ML_HS); bf16_t* SC = (bf16_t*)(shm + ML_SC); bf16_t* VTW = (bf16_t*)(shm + ML_VTW);
    const int tid = otid(), lane = tid & 63, wid = __builtin_amdgcn_readfirstlane(tid >> 6), fr = lane & 15, fq = lane >> 4;
    const int G_ = (int)gridDim.x, bid_ = obid();
    for (int k_ = 0; k_ < 2; ++k_) {
        const int item = k_ == 0 ? bid_ : (G_ == 256 ? ((bid_ >= 32 && bid_ < 64) ? 224 + bid_ : 288) : bid_ + G_);
        if (item >= 288) break;
        const int sq = item < 32 ? 0 : 1 + ((item - 32) >> 5), rem = item < 32 ? item : ((item - 32) & 31), dh = rem >> 2, sl = rem & 3, dir = dh >> 2, h = dh & 3;
        int tokbase, N;
        if (sq == 0) { tokbase = 0; N = 8192; } else { tokbase = 8192 + (sq - 1) * 4096; N = 4096; }
        const int nchunks = N >> 6;
        bf16_t* hout = dir ? hb : hf;
        for (int i = tid; i < 80 * 264 / 2; i += 512) ((unsigned*)CT)[i] = 0u;
        for (int i = tid; i < 16 * 72; i += 512) VT[64 * 72 + i] = (i < 72) ? (bf16_t)0x3F80 : (bf16_t)0;
        for (int i = tid; i < 16 * 72; i += 512) VTW[64 * 72 + i] = (bf16_t)0;
        f32x4 state[2][5];
#pragma unroll
        for (int a = 0; a < 2; ++a)
#pragma unroll
            for (int b = 0; b < 5; ++b) state[a][b] = (f32x4){0.f, 0.f, 0.f, 0.f};
        float mcar = 0.f;
        const int sgn = dir ? -1 : 1;
        const float gbi = gate_b[dir * 4 + h], gbf = gate_b[8 + dir * 4 + h];
        u32x4 qreg[4], kreg[4], vreg; float ipre = 0.f, fpre = 0.f;
#define ML_LOAD(cc) do { const int cb_ = dir ? (tokbase + N - 1 - 64 * (cc)) : (tokbase + 64 * (cc)); \
            _Pragma("unroll") for (int i = 0; i < 4; ++i) { const int id = tid + 512 * i, row = id >> 5, c8 = (id & 31) * 8; \
                const bf16_t* p_ = qk + (size_t)(cb_ + sgn * row) * 2048 + h * 256 + c8; qreg[i] = *(const u32x4*)p_; kreg[i] = *(const u32x4*)(p_ + 1024); } \
            { const int row = tid >> 3, c8 = (tid & 7) * 8; vreg = *(const u32x4*)(vo + (size_t)(cb_ + sgn * row) * 2048 + h * 256 + sl * 64 + c8); } \
            } while (0)
#define ML_GLOAD(cc) do { const int cb_ = dir ? (tokbase + N - 1 - 64 * (cc)) : (tokbase + 64 * (cc)); const size_t tk = (size_t)(cb_ + sgn * lane); \
            ipre = gates[tk * 16 + dir * 4 + h]; fpre = gates[tk * 16 + 8 + dir * 4 + h]; } while (0)
        ML_LOAD(0);
        u32x4 pendw = (u32x4){0u, 0u, 0u, 0u}; bf16_t* pend_p = hout;
#define ML_GATES(cc) do { float* vec_ = (float*)(shm + ML_VEC) + ((cc) & 1) * 328; \
            const float ip = ipre + gbi, fp = fpre + gbf; \
            const float lf = fminf(fp, 0.f) - log1pf(__expf(-fabsf(fp))); \
            float b = lf; \
            _Pragma("unroll") for (int o = 1; o < 64; o <<= 1) { const float t = __shfl_up(b, o); if (lane >= o) b += t; } \
            const float colv = ip - b; float pm = colv; \
            _Pragma("unroll") for (int o = 1; o < 64; o <<= 1) { const float t = __shfl_up(pm, o); if (lane >= o) pm = fmaxf(pm, t); } \
            const float mm = fmaxf(mcar, pm); const float blast = __shfl(b, 63), pm63 = __shfl(pm, 63); const float mm63 = fmaxf(mcar, pm63); \
            vec_[lane] = -mm; vec_[64 + lane] = colv; vec_[128 + lane] = __expf(mcar - mm); vec_[192 + lane] = __expf(-(b + mm)); \
            vec_[256 + lane] = __expf(colv - mm63); if (lane == 0) vec_[320] = __expf(mcar - mm63); \
            mcar = blast + mm63; } while (0)
        if (wid == 4) { ML_GLOAD(0); ML_GATES(0); if (nchunks > 1) ML_GLOAD(1); }
        __syncthreads();
        for (int c = 0; c < nchunks; ++c) {
            float* vec = (float*)(shm + ML_VEC) + (c & 1) * 328;
            const int cbase = dir ? (tokbase + N - 1 - 64 * c) : (tokbase + 64 * c);
#pragma unroll
            for (int i = 0; i < 4; ++i) { const int id = tid + 512 * i, row = id >> 5, c8 = (id & 31) * 8;
                *(u32x4*)(Qs + row * 264 + c8) = qreg[i]; *(u32x4*)(Ks + row * 264 + c8) = kreg[i]; }
            { const int row = tid >> 3, c8 = (tid & 7) * 8;
              VT[(c8 + 0) * 72 + row] = (bf16_t)(vreg.x & 0xffff); VT[(c8 + 1) * 72 + row] = (bf16_t)(vreg.x >> 16);
              VT[(c8 + 2) * 72 + row] = (bf16_t)(vreg.y & 0xffff); VT[(c8 + 3) * 72 + row] = (bf16_t)(vreg.y >> 16);
              VT[(c8 + 4) * 72 + row] = (bf16_t)(vreg.z & 0xffff); VT[(c8 + 5) * 72 + row] = (bf16_t)(vreg.z >> 16);
              VT[(c8 + 6) * 72 + row] = (bf16_t)(vreg.w & 0xffff); VT[(c8 + 7) * 72 + row] = (bf16_t)(vreg.w >> 16); }
            { const int row = tid >> 3, c8 = (tid & 7) * 8; const float wr_ = vec[256 + row];
              const unsigned q0 = pk2(bflo(vreg.x) * wr_, bfhi(vreg.x) * wr_), q1 = pk2(bflo(vreg.y) * wr_, bfhi(vreg.y) * wr_), q2 = pk2(bflo(vreg.z) * wr_, bfhi(vreg.z) * wr_), q3 = pk2(bflo(vreg.w) * wr_, bfhi(vreg.w) * wr_);
              VTW[(c8 + 0) * 72 + row] = (bf16_t)(q0 & 0xffff); VTW[(c8 + 1) * 72 + row] = (bf16_t)(q0 >> 16);
              VTW[(c8 + 2) * 72 + row] = (bf16_t)(q1 & 0xffff); VTW[(c8 + 3) * 72 + row] = (bf16_t)(q1 >> 16);
              VTW[(c8 + 4) * 72 + row] = (bf16_t)(q2 & 0xffff); VTW[(c8 + 5) * 72 + row] = (bf16_t)(q2 >> 16);
              VTW[(c8 + 6) * 72 + row] = (bf16_t)(q3 & 0xffff); VTW[(c8 + 7) * 72 + row] = (bf16_t)(q3 >> 16);
              if (tid < 64) VTW[64 * 72 + tid] = f2bf(vec[256 + tid]); }
            asm volatile("" ::: "memory");
            if (c > 0) *(u32x4*)pend_p = pendw;
            if (c + 1 < nchunks) ML_LOAD(c + 1);
            __syncthreads();
            const int tt = wid & 3, hf2 = wid >> 2;
            bf16x8 qf[8];
#pragma unroll
            for (int kk = 0; kk < 8; ++kk) qf[kk] = *(const bf16x8*)(Qs + (tt * 16 + fr) * 264 + kk * 32 + fq * 8);
#pragma unroll
            for (int q2 = 0; q2 < 2; ++q2) { const int st = hf2 * 2 + q2; f32x4 acc = (f32x4){0.f, 0.f, 0.f, 0.f};
                if (st <= tt) {
#pragma unroll
                    for (int kk = 0; kk < 8; ++kk) { const bf16x8 b = *(const bf16x8*)(Ks + (st * 16 + fr) * 264 + kk * 32 + fq * 8);
                        acc = __builtin_amdgcn_mfma_f32_16x16x32_bf16(qf[kk], b, acc, 0, 0, 0); } }
                const int s = st * 16 + fr; const float cv = vec[64 + s];
                float sv[4];
#pragma unroll
                for (int j = 0; j < 4; ++j) { const int t = tt * 16 + fq * 4 + j; sv[j] = (s <= t) ? acc[j] * __expf(vec[t] + cv) : 0.f; }
                const unsigned w01 = pk2(sv[0], sv[1]), w23 = pk2(sv[2], sv[3]);
                bf16_t* scp = SC + (tt * 16 + fq * 4) * 72 + s;
                scp[0] = (bf16_t)(w01 & 0xffff); scp[72] = (bf16_t)(w01 >> 16); scp[144] = (bf16_t)(w23 & 0xffff); scp[216] = (bf16_t)(w23 >> 16); }
            { const float decay = vec[320];
#pragma unroll
              for (int dt = 0; dt < 2; ++dt)
#pragma unroll
                  for (int et = 0; et < 5; ++et) state[dt][et] = state[dt][et] * decay;
              { u32x2 r000, r001, r010, r011, r100, r101, r110, r111;
                const unsigned kaddr = (unsigned)(size_t)(LAS unsigned char*)shm + ML_KS + (unsigned)(((fq * 8 + (fr >> 2)) * 264 + wid * 32 + 4 * (fr & 3)) * 2);
                asm volatile("ds_read_b64_tr_b16 %0, %8\n\tds_read_b64_tr_b16 %1, %8 offset:32\n\tds_read_b64_tr_b16 %2, %8 offset:2112\n\tds_read_b64_tr_b16 %3, %8 offset:2144\n\t"
                             "ds_read_b64_tr_b16 %4, %8 offset:16896\n\tds_read_b64_tr_b16 %5, %8 offset:16928\n\tds_read_b64_tr_b16 %6, %8 offset:19008\n\tds_read_b64_tr_b16 %7, %8 offset:19040\n\t"
                             "s_waitcnt lgkmcnt(0)"
                             : "=&v"(r000), "=&v"(r001), "=&v"(r010), "=&v"(r011), "=&v"(r100), "=&v"(r101), "=&v"(r110), "=&v"(r111) : "v"(kaddr) : "memory");
                bf16x8 a[2][2];
                { const u32x4 t0 = (u32x4){r000.x, r000.y, r010.x, r010.y}; a[0][0] = *(const bf16x8*)&t0; const u32x4 t1 = (u32x4){r001.x, r001.y, r011.x, r011.y}; a[0][1] = *(const bf16x8*)&t1;
                  const u32x4 t2 = (u32x4){r100.x, r100.y, r110.x, r110.y}; a[1][0] = *(const bf16x8*)&t2; const u32x4 t3 = (u32x4){r101.x, r101.y, r111.x, r111.y}; a[1][1] = *(const bf16x8*)&t3; }
#pragma unroll
                for (int kk = 0; kk < 2; ++kk)
#pragma unroll
                  for (int et = 0; et < 5; ++et) { const bf16x8 b = *(const bf16x8*)(VTW + (et * 16 + fr) * 72 + kk * 32 + fq * 8);
#pragma unroll
                      for (int dt = 0; dt < 2; ++dt) state[dt][et] = __builtin_amdgcn_mfma_f32_16x16x32_bf16(a[kk][dt], b, state[dt][et], 0, 0, 0); } } }
            if (wid == 4 && c + 1 < nchunks) { ML_GATES(c + 1); if (c + 2 < nchunks) ML_GLOAD(c + 2); }
            __syncthreads();
            { const int et0 = hf2 ? 3 : 0, net = hf2 ? 2 : 3;
              bf16x8 scf[2];
#pragma unroll
              for (int kk = 0; kk < 2; ++kk) scf[kk] = *(const bf16x8*)(SC + (tt * 16 + fr) * 72 + kk * 32 + fq * 8);
              const f32x4 ain = *(const f32x4*)(vec + 128 + tt * 16 + fq * 4);
#pragma unroll
              for (int e = 0; e < 3; ++e) { if (e < net) { const int et = et0 + e; f32x4 acc = (f32x4){0.f, 0.f, 0.f, 0.f};
#pragma unroll
                  for (int kk = 0; kk < 8; ++kk) { const bf16x8 b = *(const bf16x8*)(CT + (et * 16 + fr) * 264 + kk * 32 + fq * 8);
                      acc = __builtin_amdgcn_mfma_f32_16x16x32_bf16(qf[kk], b, acc, 0, 0, 0); }
                  acc = acc * ain;
#pragma unroll
                  for (int kk = 0; kk < 2; ++kk) { const bf16x8 b = *(const bf16x8*)(VT + (et * 16 + fr) * 72 + kk * 32 + fq * 8);
                      acc = __builtin_amdgcn_mfma_f32_16x16x32_bf16(scf[kk], b, acc, 0, 0, 0); }
                  if (et < 4 || fr == 0) {
#pragma unroll
                      for (int j = 0; j < 4; ++j) HS[(tt * 16 + fq * 4 + j) * ML_HSLD + et * 16 + fr] = acc[j]; } } } }
            __syncthreads();
#pragma unroll
            for (int dt = 0; dt < 2; ++dt) { const int d0 = (wid * 2 + dt) * 16 + fq * 4;
#pragma unroll
                for (int et = 0; et < 5; ++et) { u32x2 w; w.x = pk2(state[dt][et][0], state[dt][et][1]); w.y = pk2(state[dt][et][2], state[dt][et][3]);
                    *(u32x2*)(CT + (et * 16 + fr) * 264 + d0) = w; } }
            { const int t = tid >> 3, ec = (tid & 7) * 8;
              const float den = HS[t * ML_HSLD + 64]; const float dn = fmaxf(fabsf(den), vec[192 + t]); const float inv = __builtin_amdgcn_rcpf(dn);
              const f32x4 n0 = *(const f32x4*)(HS + t * ML_HSLD + ec), n1 = *(const f32x4*)(HS + t * ML_HSLD + ec + 4);
              pend_p = hout + (size_t)(cbase + sgn * t) * 1024 + h * 256 + sl * 64 + ec;
              pendw.x = pk2(n0[0] * inv, n0[1] * inv); pendw.y = pk2(n0[2] * inv, n0[3] * inv); pendw.z = pk2(n1[0] * inv, n1[1] * inv); pendw.w = pk2(n1[2] * inv, n1[3] * inv); }
        }
        *(u32x4*)pend_p = pendw;
        __syncthreads();
    }
#undef ML_LOAD
#undef ML_GLOAD
#undef ML_GATES
}

__device__ void mlnorm_phase(const bf16_t* hf, const bf16_t* hb, const float* ng, const bf16_t* vo, bf16_t* ym) {
    const int tid_ = otid(); const int lane = tid_ & 63, wv = obid() * 8 + (tid_ >> 6), nw = gridDim.x * 8;
    for (int t = wv; t < TH; t += nw) {
#pragma unroll
        for (int h = 0; h < 4; ++h) { const int c = h * 256 + lane * 4; const size_t ix = (size_t)t * 1024 + c;
            const u32x2 ha = *(const u32x2*)(hf + ix), hc = *(const u32x2*)(hb + ix);
            f32x4 v = (f32x4){bflo(ha.x) + bflo(hc.x), bfhi(ha.x) + bfhi(hc.x), bflo(ha.y) + bflo(hc.y), bfhi(ha.y) + bfhi(hc.y)};
            const float mu = wave_sum((v[0] + v[1]) + (v[2] + v[3])) * (1.0f / 256.0f);
            v = v - mu;
            const float rstd = rsqrtf(wave_sum((v[0] * v[0] + v[1] * v[1]) + (v[2] * v[2] + v[3] * v[3])) * (1.0f / 256.0f) + LN_EPS);
            const f32x4 gg = *(const f32x4*)(ng + c);
            const u32x2 ow = *(const u32x2*)(vo + (size_t)t * 2048 + 1024 + c);
            const float y0 = v[0] * rstd * gg[0] * bflo(ow.x), y1 = v[1] * rstd * gg[1] * bfhi(ow.x), y2 = v[2] * rstd * gg[2] * bflo(ow.y), y3 = v[3] * rstd * gg[3] * bfhi(ow.y);
            u32x2 w; w.x = pk2(y0, y1); w.y = pk2(y2, y3);
            *(u32x2*)(ym + ix) = w; }
    }
}


#define XB_TMO      128
#define XB_XCNT(j)  (256  + 64 * (j))
#define XB_XSUB(j)  (1280 + 64 * (j))
#define XB_XGEN(j)  (2304 + 64 * (j))
#define XB_TOP      3328
#define XB_TOPGEN   3392
#define XCD_BAR_WORDS 3456
#define XB_SPIN_CAP (1u << 20)
__device__ __forceinline__ unsigned xb_ld(unsigned* p)              { return __hip_atomic_load(p, __ATOMIC_RELAXED, __HIP_MEMORY_SCOPE_AGENT); }
__device__ __forceinline__ unsigned xb_add(unsigned* p, unsigned v) { return __hip_atomic_fetch_add(p, v, __ATOMIC_RELAXED, __HIP_MEMORY_SCOPE_AGENT); }
__device__ __forceinline__ unsigned xb_xcc_id() { return (unsigned)__builtin_amdgcn_s_getreg((3 << 11) | 20) & 0xFu; }
#define XB_SPIN(cond, bar) do { unsigned _sp = 0; while (cond) { __builtin_amdgcn_s_sleep(1); \
    if ((++_sp & 255u) == 0u) { if (xb_ld(&(bar)[XB_TMO])) break; if (_sp > XB_SPIN_CAP) { atomicAdd(&(bar)[XB_TMO], 1u); break; } } } } while (0)
__device__ __forceinline__ void xcd_barrier_post(unsigned* bar) { if (threadIdx.x == 0) (void)xb_add(&bar[XB_XCNT(xb_xcc_id())], 1u); }
__device__ __forceinline__ void xcd_barrier_complete(unsigned* bar, unsigned x, unsigned& nloc, unsigned& nx) {
    const unsigned G = gridDim.x * gridDim.y * gridDim.z;
    unsigned sum, cnt, mine, sp = 0u;
    for (;;) {
        sum = 0u; cnt = 0u; mine = 0u;
#pragma unroll
        for (unsigned j = 0; j < 16; ++j) { const unsigned c = xb_ld(&bar[XB_XCNT(j)]); sum += c; cnt += (c > 0u) ? 1u : 0u; mine = (j == x) ? c : mine; }
        if (sum == G) break;
        __builtin_amdgcn_s_sleep(1);
        if ((++sp & 255u) == 0u) { if (xb_ld(&bar[XB_TMO])) break; if (sp > XB_SPIN_CAP) { atomicAdd(&bar[XB_TMO], 1u); break; } }
    }
    nloc = mine > 0u ? mine : 1u; nx = cnt > 0u ? cnt : 1u;
}
__device__ __forceinline__ void xcd_barrier(unsigned* bar, volatile LAS unsigned* st) {
    asm volatile("s_waitcnt vmcnt(0)" ::: "memory");
    __syncthreads();
    if (threadIdx.x == 0) {
        __builtin_amdgcn_s_waitcnt(0);
        const unsigned x = xb_xcc_id();
        unsigned nloc = st[0], nx = st[1];
        if (nloc == 0u) { xcd_barrier_complete(bar, x, nloc, nx); st[0] = nloc; st[1] = nx; }
        const unsigned old = xb_add(&bar[XB_XSUB(x)], 1u);
        const unsigned gen = old / nloc;
        if (old + 1u == (gen + 1u) * nloc) {
            __builtin_amdgcn_fence(__ATOMIC_RELEASE, "agent");
            asm volatile("s_waitcnt vmcnt(0)" ::: "memory");
            const unsigned og = xb_add(&bar[XB_TOP], 1u);
            const unsigned tg = og / nx;
            if (og + 1u == (tg + 1u) * nx) xb_add(&bar[XB_TOPGEN], 1u);
            else XB_SPIN(xb_ld(&bar[XB_TOPGEN]) == tg, bar);
            __builtin_amdgcn_fence(__ATOMIC_ACQUIRE, "agent");
            xb_add(&bar[XB_XGEN(x)], 1u);
            asm volatile("s_waitcnt vmcnt(0)" ::: "memory");
        } else {
            XB_SPIN(xb_ld(&bar[XB_XGEN(x)]) == gen, bar);
            __builtin_amdgcn_fence(__ATOMIC_ACQUIRE, "agent");
            asm volatile("s_waitcnt vmcnt(0)" ::: "memory");
        }
    }
    __syncthreads();
}

__global__ void __launch_bounds__(512, 2) mega(Params p) {
    extern __shared__ __attribute__((aligned(16))) unsigned char shm[];
    cg::grid_group grid = cg::this_grid();
    unsigned* bar = (unsigned*)(p.ws + OFF_BAR);
    volatile LAS unsigned* bst = (volatile LAS unsigned*)((LAS unsigned char*)shm + LDS_BYTES - 16);
    if (threadIdx.x == 0) { bst[0] = 0u; bst[1] = 0u; }
    __syncthreads();
    xcd_barrier_post(bar);
    for (int ph = 0; ph < 17; ++ph) {
        if (ph == 8) continue;
        unsigned char* ws = p.ws;
        float* out = p.out;
        bf16_t* xb = (bf16_t*)(ws + OFF_XB); bf16_t* Hb = (bf16_t*)(ws + OFF_H);
        int kind;
        if (ph == 0) kind = 0; else if (ph == 1 || ph == 14) kind = 1; else if (ph == 2 || ph == 12 || ph == 15) kind = 2; else if (ph == 3 || ph == 8 || ph == 13 || ph == 16) kind = 3;
        else if (ph == 4 || ph == 9) kind = 4; else if (ph == 5) kind = 5; else if (ph == 6) kind = 6; else if (ph == 7) kind = 7; else kind = 8;
        switch (kind) {
        case 0: {
            const int bid = obid(), nb = (int)gridDim.x;
            convert_w<1>(p.in[2], DM, 2 * DFF, (bf16_t*)(ws + OFF_WGU_A), 2 * DFF, shm, bid, nb);
            convert_w<2>(p.in[6], DM, 11280, (bf16_t*)(ws + OFF_WIN), NIN_PAD, shm, bid, nb);
            for (int i = 0; i < 4; ++i) {
                const float* W = i == 0 ? p.in[3] : i == 1 ? p.in[12] : i == 2 ? p.in[13] : p.in[14];
                const size_t off = i == 0 ? OFF_WDN_A : i == 1 ? OFF_WPA : i == 2 ? OFF_WPM : OFF_WOUT;
                const int K = i < 1 ? DFF : i < 3 ? 1024 : DM;
                convert_w<0>(W, K, DM, (bf16_t*)(ws + off), DM, shm, bid, nb);
            }
            convert_x(p.in[0], xb, (size_t)8192 * DM);
            convert_x(p.in[1], xb + (size_t)8192 * DM, (size_t)32768 * DM);
        } break;
        case 1: {
            EpiSwiglu E; E.H = Hb;
            run_gemm(shm, xb, (const bf16_t*)(ws + OFF_WGU_A), T_ALL, 2 * DFF, DM, E);
        } break;
        case 2: {
            bf16_t* sb = (bf16_t*)out;
            EpiResid E; const bf16_t* A; const bf16_t* Bt; int K;
            E.stats = nullptr; E.lg = nullptr; E.lb = nullptr; E.x_bf16 = ph == 2;
            if (ph == 2) { A = Hb; Bt = (const bf16_t*)(ws + OFF_WDN_A); K = DFF; E.xres = xb; E.out = sb; E.scale = 0.5f; }
            else if (ph == 15) { A = Hb; Bt = (const bf16_t*)(ws + OFF_WDN_B); K = DFF; E.xres = sb; E.out = xb; E.scale = 0.5f;
                E.stats = (const float*)(ws + OFF_STATS_M); E.lg = p.in[15]; E.lb = p.in[16]; }
            else { A = (const bf16_t*)(ws + OFF_ZNA); Bt = (const bf16_t*)(ws + OFF_WOUT); K = DM; E.xres = sb; E.out = sb; E.scale = 1.0f;
                E.stats = (const float*)(ws + OFF_STATS_A); E.lg = p.in[4]; E.lb = p.in[5]; }
            run_gemm(shm, A, Bt, T_ALL, DM, K, E);
        } break;
        case 3: {
            const int gi = (ph == 3 || ph == 8) ? 4 : ph == 13 ? 15 : 19;
            const bf16_t* X = ph == 16 ? (const bf16_t*)xb : (const bf16_t*)out;
            ln_phase(X, p.in[gi], p.in[gi + 1], ph == 16 ? nullptr : xb, ph == 16 ? out : nullptr, ph == 8 ? T_ALL / 2 : T_ALL,
                     (ph == 3 || ph == 8) ? (float*)(ws + OFF_STATS_A) : ph == 13 ? (float*)(ws + OFF_STATS_M) : nullptr);
        } break;
        case 4: {
            const int nparts = ph == 4 ? 2 : 1;
            for (int part = 0; part < nparts; ++part) {
                EpiInproj E; E.zna = (bf16_t*)(ws + OFF_ZNA); E.zqk = (bf16_t*)(ws + OFF_ZQK); E.vo = (bf16_t*)(ws + OFF_VO); E.g = (bf16_t*)(ws + OFF_G);
                const bf16_t* win = (const bf16_t*)(ws + OFF_WIN);
                E.vt = (ph == 4 && part) ? (bf16_t*)(ws + OFF_VTN) : nullptr; E.gmode = ph == 9;
                if (ph == 9) run_gemm(shm, xb, win + (size_t)6144 * DM, T_ALL, 4096, DM, E);
                else if (part == 0) run_gemm(shm, xb, win, T_ALL, 6144, DM, E);
                else { run_gemm(shm, win + (size_t)10496 * DM, xb, 1024, T_ALL, DM, E);
                    const int nfull = (4 * (T_ALL / 256)) % (int)gridDim.x;
                    if (nfull > 0 && obid() >= nfull) convert_w<0>(p.in[18], DFF, DM, (bf16_t*)(ws + OFF_WDN_B), DM, shm, obid() - nfull, (int)gridDim.x - nfull); }
            }
        } break;
        case 5: gates_phase(xb, (const bf16_t*)(ws + OFF_WIN) + (size_t)10240 * DM, (float*)(ws + OFF_GATES));
            conv_phase((const bf16_t*)(ws + OFF_ZQK), p.in[8], p.in[9], (bf16_t*)(ws + OFF_QK), 0);
            if (obid() == 0 && otid() < 8) *(unsigned*)(ws + OFF_CTR + 64 * otid()) = 0u;
            break;
        case 6: {
            const int bid = obid();
            mlstm_phase((const bf16_t*)(ws + OFF_QK), (const bf16_t*)(ws + OFF_VO), (const float*)(ws + OFF_GATES), p.in[10], (bf16_t*)(ws + OFF_HF), (bf16_t*)out + (size_t)T_ALL * DM, shm);
            if (bid >= 64) {
                convert_w<1>(p.in[17], DM, 2 * DFF, (bf16_t*)(ws + OFF_WGU_B), 2 * DFF, shm, bid - 64, (int)gridDim.x - 64);
                if ((4 * (T_ALL / 256)) % (int)gridDim.x == 0) convert_w<0>(p.in[18], DFF, DM, (bf16_t*)(ws + OFF_WDN_B), DM, shm, bid - 64, (int)gridDim.x - 64);
            }
            na_phase((const bf16_t*)(ws + OFF_ZNA), (const bf16_t*)(ws + OFF_VTN), p.in[7], (bf16_t*)(ws + OFF_ZQK), 0, (unsigned*)(ws + OFF_CTR));
        } break;
        case 7: mlnorm_phase((const bf16_t*)(ws + OFF_HF), (const bf16_t*)out + (size_t)T_ALL * DM, p.in[11], (const bf16_t*)(ws + OFF_VO), (bf16_t*)(ws + OFF_ZQK) + (size_t)TH * 1024); break;
        default: {
            const bool pm_ = ph == 11;
            EpiMerge E; E.gate = (const bf16_t*)(ws + OFF_G) + (pm_ ? 2048 : 0); E.merged = (bf16_t*)(ws + OFF_ZNA); E.accum = pm_;
            const bf16_t* A = (const bf16_t*)(ws + OFF_ZQK) + (pm_ ? (size_t)TH * 1024 : 0);
            run_gemm(shm, A, (const bf16_t*)(ws + (pm_ ? OFF_WPM : OFF_WPA)), T_ALL, DM, 1024, E);
        } break;
        }
        if (ph == 0) grid.sync();
        else if (ph != 16 && ph != 10) xcd_barrier(bar, bst);
    }
}

extern "C" void kernel_launch(void* const* d_in, const int* in_sizes, int n_in, void* d_out, int out_size, void* d_ws, size_t ws_size, hipStream_t stream) {
    static int grid_blocks = 0;
    if (grid_blocks == 0) {
        if (n_in != 21 || ws_size < ((size_t)1 << 30)) { fprintf(stderr, "kernel_launch: unexpected n_in %d / ws %zu\n", n_in, ws_size); grid_blocks = -1; return; }
        int dev = 0, cus = 0, per_cu = 0;
        hipGetDevice(&dev);
        hipDeviceGetAttribute(&cus, hipDeviceAttributeMultiprocessorCount, dev);
        if (hipFuncSetAttribute((const void*)mega, hipFuncAttributeMaxDynamicSharedMemorySize, LDS_BYTES) != hipSuccess) { fprintf(stderr, "kernel_launch: hipFuncSetAttribute failed\n"); grid_blocks = -1; return; }
        hipOccupancyMaxActiveBlocksPerMultiprocessor(&per_cu, (const void*)mega, 512, LDS_BYTES);
        if (per_cu < 1) { fprintf(stderr, "kernel_launch: occupancy query says %d blocks per CU\n", per_cu); per_cu = 1; }
        grid_blocks = cus * 1;
    }
    if (grid_blocks < 0) return;
    Params p{};
    for (int i = 0; i < 21; ++i) p.in[i] = (const float*)d_in[i];
    p.out = (float*)d_out; p.ws = (unsigned char*)d_ws;
    if (hipMemsetAsync((unsigned char*)d_ws + OFF_BAR, 0, 16384, stream) != hipSuccess) { fprintf(stderr, "kernel_launch: memset of the barrier words failed\n"); return; }
    void* args[] = {&p};
    hipError_t e = hipLaunchCooperativeKernel((const void*)mega, dim3(grid_blocks), dim3(512), args, LDS_BYTES, stream);
    if (e != hipSuccess) fprintf(stderr, "cooperative launch failed: %s (grid %d)\n", hipGetErrorString(e), grid_blocks);
}
```

```cpp
#include <hip/hip_runtime.h>
#include <hip/hip_cooperative_groups.h>
#include <cstdio>
namespace cg = cooperative_groups;

#define LAS __attribute__((address_space(3)))
typedef unsigned short bf16_t;
typedef short bf16x8 __attribute__((ext_vector_type(8)));
typedef float f32x4 __attribute__((ext_vector_type(4)));
typedef unsigned u32x4 __attribute__((ext_vector_type(4)));
typedef unsigned u32x2 __attribute__((ext_vector_type(2)));

constexpr int T_ALL = 40960, TH = T_ALL, DM = 2048, DFF = 5632;
constexpr int NIN_PAD = 11520;
constexpr float ALPHA = 1.189207115002721f;
constexpr float LN_EPS = 1e-5f;
constexpr int LDS_BYTES = 163840;

constexpr size_t SZ_WGU = (size_t)2 * DFF * DM * 2, SZ_WDN = (size_t)DM * DFF * 2, SZ_WIN = (size_t)NIN_PAD * DM * 2;
constexpr size_t SZ_WPA = (size_t)DM * 1024 * 2, SZ_WOUT = (size_t)DM * DM * 2;
constexpr size_t OFF_WGU_A = 0, OFF_WDN_A = OFF_WGU_A + SZ_WGU, OFF_WIN = OFF_WDN_A + SZ_WDN, OFF_WPA = OFF_WIN + SZ_WIN,
                 OFF_WPM = OFF_WPA + SZ_WPA, OFF_WOUT = OFF_WPM + SZ_WPA, OFF_WGU_B = OFF_WGU_A, OFF_WDN_B = OFF_WDN_A,
                 OFF_XB = OFF_WOUT + SZ_WOUT, OFF_BIG = OFF_XB + (size_t)T_ALL * DM * 2;
constexpr size_t OFF_H = OFF_BIG;
constexpr size_t SZ_T2K = (size_t)T_ALL * 2048 * 2;
constexpr size_t OFF_ZNA = OFF_BIG;
constexpr size_t OFF_VTN = OFF_ZNA + SZ_T2K;
constexpr size_t OFF_ZQK = OFF_VTN + SZ_T2K / 2;
constexpr size_t OFF_QK = OFF_ZQK + SZ_T2K;
constexpr size_t OFF_VO = OFF_QK + SZ_T2K;
constexpr size_t OFF_G = OFF_QK;
constexpr size_t OFF_GATES = OFF_VO + SZ_T2K, SZ_GATES = (size_t)T_ALL * 16 * 4;
constexpr size_t OFF_HF = OFF_ZQK + SZ_T2K / 2, OFF_HB = OFF_XB;
constexpr size_t OFF_CTR = OFF_GATES + SZ_GATES;
constexpr size_t OFF_STATS_A = OFF_CTR + 1024, OFF_STATS_M = OFF_STATS_A + (size_t)T_ALL * 8;
constexpr size_t OFF_BAR = OFF_STATS_M + (size_t)T_ALL * 8;
constexpr size_t WS_END = OFF_BAR + 16384;
static_assert(OFF_H + (size_t)T_ALL * DFF * 2 <= (size_t)1 << 30, "H fits");
static_assert(WS_END <= (size_t)1 << 30, "mixer fits");

struct Params {
    const float* in[21];
    float* out;
    unsigned char* ws;
};

__device__ __forceinline__ float bf2f(unsigned short b) { return __uint_as_float(((unsigned)b) << 16); }
__device__ __forceinline__ float bflo(unsigned w) { return __uint_as_float(w << 16); }
__device__ __forceinline__ float bfhi(unsigned w) { return __uint_as_float(w & 0xffff0000u); }
__device__ __forceinline__ unsigned short f2bf(float f) { unsigned u = __float_as_uint(f); u += 0x7FFFu + ((u >> 16) & 1u); return (unsigned short)(u >> 16); }
__device__ __forceinline__ unsigned pk2(float lo, float hi) { unsigned r; asm("v_cvt_pk_bf16_f32 %0, %1, %2" : "=v"(r) : "v"(lo), "v"(hi)); return r; }
typedef _Float16 h16x2 __attribute__((ext_vector_type(2)));
__device__ __forceinline__ float hlo(unsigned w) { return (float)__builtin_bit_cast(h16x2, w)[0]; }
__device__ __forceinline__ float hhi(unsigned w) { return (float)__builtin_bit_cast(h16x2, w)[1]; }
__device__ __forceinline__ unsigned pkh(float lo, float hi) { h16x2 r; r[0] = (_Float16)lo; r[1] = (_Float16)hi; return __builtin_bit_cast(unsigned, r); }
__device__ __forceinline__ float sigmoidf_(float x) { return __builtin_amdgcn_rcpf(1.0f + __builtin_amdgcn_exp2f(-1.4426950408889634f * x)); }
__device__ __forceinline__ int otid() { int t = threadIdx.x; asm volatile("" : "+v"(t)); return t; }
__device__ __forceinline__ int obid() { int b = blockIdx.x; asm volatile("" : "+s"(b)); return b; }

namespace pg8 {
constexpr int BM = 256, BK = 64, HALF = 128, HTB = HALF * BK * 2, NXCD = 8, WGM = 8;
__host__ __device__ __forceinline__ int lds_byte(int r, int c) { const int st = (r >> 4) * 2 + (c >> 5), rr = r & 15, cc = c & 31, ob = rr * 64 + cc * 2; return st * 1024 + (ob ^ (((ob >> 9) & 1) << 5)); }
__host__ __device__ __forceinline__ void stage_rc(int b, int& R, int& C) { const int st = b / 1024, sb = b % 1024, swz = sb ^ (((sb >> 9) & 1) << 5); R = (st >> 1) * 16 + swz / 64; C = (st & 1) * 32 + (swz % 64) / 2; }
__host__ __device__ __forceinline__ int perm32(int rho) { const int n = rho >> 4, i = rho & 15; return 8 * (i >> 2) + 4 * n + (i & 3); }
struct Unit { int pm, pn; };
struct Gemm { const bf16_t* A; const bf16_t* Bt; int M, N, K; };
struct StaticOrder {
    int nM, nN, nwg, G, c;
    __device__ void init(int M, int N, int G_, int c_) { nM = M / BM; nN = N / BM; nwg = nM * nN; G = G_; c = c_; }
    __device__ bool next(int i, Unit& u) const {
        const long L = (long)i * G + c; if (L >= nwg) return false;
        int wgid = (int)L; { const int q = nwg / NXCD, r = nwg % NXCD, xcd = wgid % NXCD, off = wgid / NXCD; wgid = (xcd < r ? xcd * (q + 1) : r * (q + 1) + (xcd - r) * q) + off; }
        const int nig = WGM * nN, gid = wgid / nig, fm = gid * WGM, gsz = (nM - fm) < WGM ? (nM - fm) : WGM;
        u.pm = fm + ((wgid % nig) % gsz); u.pn = (wgid % nig) / gsz; return true;
    }
};

template <class Epi>
__device__ __forceinline__ void gemm_phase(LAS unsigned char* lds, const Gemm g, const StaticOrder& S, const Epi& E) {
    const int tid = otid(), wid = __builtin_amdgcn_readfirstlane(tid >> 6), lane = tid & 63, wr = wid >> 2, wc = wid & 3, fr = lane & 15, fq = lane >> 4;
    const int K = g.K, nt = K / BK;
    unsigned voffA[2], voffB[2];
#pragma unroll
    for (int i = 0; i < 2; ++i) { int R, C; stage_rc(tid * 16 + i * 8192, R, C); const int Rb = Epi::PERM ? ((R & ~31) + perm32(R & 31)) : R;
        voffA[i] = (unsigned)(R * K + C) * 2u; voffB[i] = (unsigned)(Rb * K + C) * 2u; }
    const size_t kstep = (size_t)(BK * 2);
    const size_t hstep = (size_t)HALF * K * 2;
    const size_t tstep = 2 * hstep;
    const unsigned ldsw = (unsigned)wid * 1024u;
    const int aoff = lds_byte(wr * 64 + fr, fq * 8), boff = lds_byte(wc * 32 + fr, fq * 8);
#define PG8_SA(b, h) (((b) * 2 + (h)) * HTB)
#define PG8_SB(b, h) ((4 + (b) * 2 + (h)) * HTB)
#define PG8_STAGE(bufoff, gbase, voff) do { _Pragma("unroll") for (int _i = 0; _i < 2; ++_i) \
        __builtin_amdgcn_global_load_lds((const unsigned*)((const char*)(gbase) + (voff)[_i]), (LAS unsigned*)(lds + (bufoff) + ldsw + _i * 8192), 16, 0, 0); } while (0)
#define PG8_LDA(dst, b, h) do { _Pragma("unroll") for (int m = 0; m < 4; ++m) _Pragma("unroll") for (int k = 0; k < 2; ++k) dst[m][k] = *(const LAS bf16x8*)(lds + PG8_SA(b, h) + aoff + m * 2048 + k * 1024); } while (0)
#define PG8_LDB(dst, b, h) do { _Pragma("unroll") for (int n = 0; n < 2; ++n) _Pragma("unroll") for (int k = 0; k < 2; ++k) dst[n][k] = *(const LAS bf16x8*)(lds + PG8_SB(b, h) + boff + n * 2048 + k * 1024); } while (0)
#define PG8_MMA(ai, bj, At, Bt) do { __builtin_amdgcn_s_setprio(1); _Pragma("unroll") for (int m = 0; m < 4; ++m) _Pragma("unroll") for (int n = 0; n < 2; ++n) _Pragma("unroll") for (int k = 0; k < 2; ++k) \
        acc[ai][bj][m][n] = __builtin_amdgcn_mfma_f32_16x16x32_bf16(Bt[n][k], At[m][k], acc[ai][bj][m][n], 0, 0, 0); __builtin_amdgcn_s_setprio(0); } while (0)
#define PG8_WAIT_V(n) asm volatile("s_waitcnt vmcnt(" #n ")" ::: "memory")
#define PG8_WAIT_L(n) asm volatile("s_waitcnt lgkmcnt(" #n ")" ::: "memory")
#define PG8_BAR __builtin_amdgcn_s_barrier()
#define PG8_SCHED __builtin_amdgcn_sched_barrier(0)
    Unit cur, nxt; int ui = 0;
    if (!S.next(0, cur)) return;
    f32x4 acc[2][2][4][2];
#pragma unroll
    for (int a = 0; a < 2; ++a)
#pragma unroll
        for (int b = 0; b < 2; ++b)
#pragma unroll
            for (int m = 0; m < 4; ++m)
#pragma unroll
                for (int n = 0; n < 2; ++n) acc[a][b][m][n] = (f32x4){0.f, 0.f, 0.f, 0.f};
    bf16x8 At[4][2], B0[2][2], B1[2][2];
    const char* cA = (const char*)g.A + (size_t)cur.pm * tstep; const char* cB = (const char*)g.Bt + (size_t)cur.pn * tstep;
    PG8_STAGE(PG8_SB(0, 0), cB, voffB); PG8_STAGE(PG8_SA(0, 0), cA, voffA); PG8_STAGE(PG8_SB(0, 1), cB + hstep, voffB); PG8_STAGE(PG8_SA(0, 1), cA + hstep, voffA);
    if (wr == 1) PG8_BAR;
    PG8_WAIT_V(4); PG8_BAR;
    PG8_STAGE(PG8_SB(1, 0), cB + kstep, voffB); PG8_STAGE(PG8_SA(1, 0), cA + kstep, voffA); PG8_STAGE(PG8_SB(1, 1), cB + hstep + kstep, voffB);
    PG8_WAIT_V(6); PG8_BAR;
    for (;;) {
        const bool has_next = S.next(ui + 1, nxt);
        const char* nA = has_next ? (const char*)g.A + (size_t)nxt.pm * tstep : cA; const char* nB = has_next ? (const char*)g.Bt + (size_t)nxt.pn * tstep : cB;
        for (int t = 0; t < nt; t += 2) {
            const bool last = (t == nt - 2);
            const char* a1 = cA + (size_t)(t + 1) * kstep;
            const char* a2 = last ? nA : cA + (size_t)(t + 2) * kstep; const char* b2 = last ? nB : cB + (size_t)(t + 2) * kstep;
            const char* a3 = a2 + kstep; const char* b3 = b2 + kstep;
            PG8_LDB(B0, 0, 0); PG8_SCHED; PG8_LDA(At, 0, 0); PG8_STAGE(PG8_SA(1, 1), a1 + hstep, voffA);
            PG8_WAIT_L(8); PG8_BAR; PG8_WAIT_L(0); PG8_MMA(0, 0, At, B0); PG8_BAR; PG8_SCHED;
            PG8_LDB(B1, 0, 1); PG8_STAGE(PG8_SB(0, 0), b2, voffB);
            PG8_BAR; PG8_WAIT_L(0); PG8_MMA(0, 1, At, B1); PG8_BAR;
            PG8_LDA(At, 0, 1); PG8_STAGE(PG8_SA(0, 0), a2, voffA);
            PG8_BAR; PG8_WAIT_L(0); PG8_MMA(1, 0, At, B0); PG8_BAR; PG8_SCHED;
            PG8_STAGE(PG8_SB(0, 1), b2 + hstep, voffB);
            PG8_WAIT_V(6); PG8_BAR; PG8_MMA(1, 1, At, B1); PG8_BAR;
            PG8_LDB(B0, 1, 0); PG8_SCHED; PG8_LDA(At, 1, 0); PG8_STAGE(PG8_SA(0, 1), a2 + hstep, voffA);
            PG8_WAIT_L(8); PG8_BAR; PG8_WAIT_L(0); PG8_MMA(0, 0, At, B0); PG8_BAR; PG8_SCHED;
            PG8_LDB(B1, 1, 1); PG8_STAGE(PG8_SB(1, 0), b3, voffB);
            PG8_BAR; PG8_WAIT_L(0); PG8_MMA(0, 1, At, B1); PG8_BAR;
            PG8_LDA(At, 1, 1); PG8_STAGE(PG8_SA(1, 0), a3, voffA);
            PG8_BAR; PG8_WAIT_L(0); PG8_MMA(1, 0, At, B0); PG8_BAR; PG8_SCHED;
            PG8_STAGE(PG8_SB(1, 1), b3 + hstep, voffB);
            PG8_WAIT_V(6); PG8_BAR; PG8_MMA(1, 1, At, B1); PG8_BAR;
        }
        E(acc, cur, wr, wc, fr, fq);
        if (!has_next) break;
#pragma unroll
        for (int a = 0; a < 2; ++a)
#pragma unroll
            for (int b = 0; b < 2; ++b)
#pragma unroll
                for (int m = 0; m < 4; ++m)
#pragma unroll
                    for (int n = 0; n < 2; ++n) acc[a][b][m][n] = (f32x4){0.f, 0.f, 0.f, 0.f};
        cur = nxt; cA = nA; cB = nB; ++ui;
    }
    PG8_WAIT_V(0);
    if (wr == 0) PG8_BAR;
    PG8_BAR;
#undef PG8_SA
#undef PG8_SB
#undef PG8_STAGE
#undef PG8_LDA
#undef PG8_LDB
#undef PG8_MMA
#undef PG8_WAIT_V
#undef PG8_WAIT_L
#undef PG8_BAR
#undef PG8_SCHED
}
}
using pg8::Unit;
typedef f32x4 Acc[2][2][4][2];

struct EpiSwiglu {
    static constexpr bool PERM = true;
    bf16_t* H;
    __device__ __forceinline__ void operator()(const Acc& acc, const Unit& u, int wr, int wc, int fr, int fq) const {
        const int row0 = u.pm * 256 + wr * 64 + fr, col0 = u.pn * 128 + wc * 32 + 8 * fq;
#pragma unroll
        for (int ai = 0; ai < 2; ++ai)
#pragma unroll
            for (int m = 0; m < 4; ++m) {
                float h[8];
#pragma unroll
                for (int n = 0; n < 2; ++n)
#pragma unroll
                    for (int j = 0; j < 4; ++j) { const float gv = acc[ai][0][m][n][j], uv = acc[ai][1][m][n][j]; h[n * 4 + j] = gv * sigmoidf_(gv) * uv; }
                u32x4 w; w.x = pk2(h[0], h[1]); w.y = pk2(h[2], h[3]); w.z = pk2(h[4], h[5]); w.w = pk2(h[6], h[7]);
                *(u32x4*)(H + (size_t)(row0 + ai * 128 + m * 16) * DFF + col0) = w;
            }
    }
};
struct EpiResid {
    static constexpr bool PERM = true;
    const bf16_t* xres; bf16_t* out; float scale; const float* stats; const float* lg; const float* lb; int x_bf16;
    __device__ __forceinline__ void operator()(const Acc& acc, const Unit& u, int wr, int wc, int fr, int fq) const {
        const int row0 = u.pm * 256 + wr * 64 + fr, col0 = u.pn * 256 + wc * 32 + 8 * fq;
        const bf16_t* __restrict__ xr = xres; bf16_t* __restrict__ op = out;
        f32x4 gv[2][2], bv[2][2];
        if (stats) {
#pragma unroll
            for (int bj = 0; bj < 2; ++bj)
#pragma unroll
                for (int n = 0; n < 2; ++n) { gv[bj][n] = *(const f32x4*)(lg + col0 + bj * 128 + n * 4); bv[bj][n] = *(const f32x4*)(lb + col0 + bj * 128 + n * 4); } }
        u32x4 xv[2][2]; float mu[2], rs[2];
#pragma unroll
        for (int bj = 0; bj < 2; ++bj) xv[0][bj] = *(const u32x4*)(xr + (size_t)row0 * DM + col0 + bj * 128);
        mu[0] = 0.f; rs[0] = 1.f;
        if (stats) { mu[0] = stats[(size_t)row0 * 2]; rs[0] = stats[(size_t)row0 * 2 + 1]; }
#pragma unroll
        for (int gidx = 0; gidx < 8; ++gidx) {
            const int ai = gidx >> 2, m = gidx & 3;
            if (gidx + 1 < 8) { const int ai2 = (gidx + 1) >> 2, m2 = (gidx + 1) & 3; const size_t row2 = (size_t)(row0 + ai2 * 128 + m2 * 16);
#pragma unroll
                for (int bj = 0; bj < 2; ++bj) xv[(gidx + 1) & 1][bj] = *(const u32x4*)(xr + row2 * DM + col0 + bj * 128);
                mu[(gidx + 1) & 1] = 0.f; rs[(gidx + 1) & 1] = 1.f;
                if (stats) { mu[(gidx + 1) & 1] = stats[row2 * 2]; rs[(gidx + 1) & 1] = stats[row2 * 2 + 1]; } }
            const size_t rb = (size_t)(row0 + ai * 128 + m * 16) * DM + col0;
#pragma unroll
            for (int bj = 0; bj < 2; ++bj) { const u32x4 x4 = xv[gidx & 1][bj];
                f32x4 r0, r1;
                if (x_bf16) { r0 = (f32x4){bflo(x4.x), bfhi(x4.x), bflo(x4.y), bfhi(x4.y)}; r1 = (f32x4){bflo(x4.z), bfhi(x4.z), bflo(x4.w), bfhi(x4.w)}; }
                else { r0 = (f32x4){hlo(x4.x), hhi(x4.x), hlo(x4.y), hhi(x4.y)}; r1 = (f32x4){hlo(x4.z), hhi(x4.z), hlo(x4.w), hhi(x4.w)}; }
                if (stats) { r0 = (r0 - mu[gidx & 1]) * rs[gidx & 1] * gv[bj][0] + bv[bj][0]; r1 = (r1 - mu[gidx & 1]) * rs[gidx & 1] * gv[bj][1] + bv[bj][1]; }
                const f32x4 o0 = r0 * ALPHA + acc[ai][bj][m][0] * scale, o1 = r1 * ALPHA + acc[ai][bj][m][1] * scale;
                u32x4 w; w.x = pkh(o0[0], o0[1]); w.y = pkh(o0[2], o0[3]); w.z = pkh(o1[0], o1[1]); w.w = pkh(o1[2], o1[3]);
                *(u32x4*)(op + rb + bj * 128) = w; }
        }
    }
};
struct EpiInproj {
    static constexpr bool PERM = true;
    bf16_t *zna, *zqk, *vo, *g; bf16_t* vt; int gmode;
    __device__ __forceinline__ void operator()(const Acc& acc, const Unit& u, int wr, int wc, int fr, int fq) const {
        const int pn = u.pn; const int row0 = u.pm * 256 + wr * 64 + fr;
        bf16_t* base; int ld, cb; bool act;
        if (vt) { base = vt; ld = TH; cb = 256 * pn; act = false; }
        else if (gmode) { base = g; ld = 4096; cb = 256 * pn; act = true; }
        else if (pn < 8) { base = zna; ld = 2048; cb = 256 * pn; act = false; }
        else if (pn < 16) { base = zqk; ld = 2048; cb = 256 * (pn - 8); act = false; }
        else if (pn < 24) { base = vo; ld = 2048; cb = 256 * (pn - 16); act = pn >= 20; }
        else { base = g; ld = 4096; cb = 256 * (pn - 24); act = true; }
        const int col0 = cb + wc * 32 + 8 * fq;
#pragma unroll
        for (int ai = 0; ai < 2; ++ai)
#pragma unroll
            for (int m = 0; m < 4; ++m) { bf16_t* rowp = base + (size_t)(row0 + ai * 128 + m * 16) * ld + col0;
#pragma unroll
                for (int bj = 0; bj < 2; ++bj) { f32x4 v0 = acc[ai][bj][m][0], v1 = acc[ai][bj][m][1];
                    if (act) {
#pragma unroll
                        for (int j = 0; j < 4; ++j) { v0[j] = sigmoidf_(v0[j]); v1[j] = sigmoidf_(v1[j]); } }
                    u32x4 w; w.x = pk2(v0[0], v0[1]); w.y = pk2(v0[2], v0[3]); w.z = pk2(v1[0], v1[1]); w.w = pk2(v1[2], v1[3]);
                    *(u32x4*)(rowp + bj * 128) = w; } }
    }
};
struct EpiMerge {
    static constexpr bool PERM = true;
    const bf16_t* gate; bf16_t* merged; int accum;
    __device__ __forceinline__ void operator()(const Acc& acc, const Unit& u, int wr, int wc, int fr, int fq) const {
        const int row0 = u.pm * 256 + wr * 64 + fr, col0 = u.pn * 256 + wc * 32 + 8 * fq;
        const bf16_t* __restrict__ gp = gate; bf16_t* __restrict__ mg = merged;
        u32x4 gw[2][2], pw[2][2];
#pragma unroll
        for (int bj = 0; bj < 2; ++bj) { gw[0][bj] = *(const u32x4*)(gp + (size_t)row0 * 4096 + col0 + bj * 128);
            pw[0][bj] = accum ? *(const u32x4*)(mg + (size_t)row0 * 2048 + col0 + bj * 128) : (u32x4){0u, 0u, 0u, 0u}; }
#pragma unroll
        for (int gidx = 0; gidx < 8; ++gidx) {
            const int ai = gidx >> 2, m = gidx & 3;
            if (gidx + 1 < 8) { const int ai2 = (gidx + 1) >> 2, m2 = (gidx + 1) & 3; const size_t row2 = (size_t)(row0 + ai2 * 128 + m2 * 16);
#pragma unroll
                for (int bj = 0; bj < 2; ++bj) { gw[(gidx + 1) & 1][bj] = *(const u32x4*)(gp + row2 * 4096 + col0 + bj * 128);
                    pw[(gidx + 1) & 1][bj] = accum ? *(const u32x4*)(mg + row2 * 2048 + col0 + bj * 128) : (u32x4){0u, 0u, 0u, 0u}; } }
            const size_t row = (size_t)(row0 + ai * 128 + m * 16);
#pragma unroll
            for (int bj = 0; bj < 2; ++bj) { const u32x4 g4 = gw[gidx & 1][bj], p4 = pw[gidx & 1][bj];
                float o[8]; const f32x4 v0 = acc[ai][bj][m][0], v1 = acc[ai][bj][m][1];
                o[0] = bflo(g4.x) * v0[0] + bflo(p4.x); o[1] = bfhi(g4.x) * v0[1] + bfhi(p4.x); o[2] = bflo(g4.y) * v0[2] + bflo(p4.y); o[3] = bfhi(g4.y) * v0[3] + bfhi(p4.y);
                o[4] = bflo(g4.z) * v1[0] + bflo(p4.z); o[5] = bfhi(g4.z) * v1[1] + bfhi(p4.z); o[6] = bflo(g4.w) * v1[2] + bflo(p4.w); o[7] = bfhi(g4.w) * v1[3] + bfhi(p4.w);
                u32x4 w; w.x = pk2(o[0], o[1]); w.y = pk2(o[2], o[3]); w.z = pk2(o[4], o[5]); w.w = pk2(o[6], o[7]);
                *(u32x4*)(mg + row * 2048 + col0 + bj * 128) = w; }
        }
    }
};

template <class Epi>
__device__ __forceinline__ void run_gemm(unsigned char* shm, const bf16_t* A, const bf16_t* Bt, int M, int N, int K, const Epi& E, int crot = 0) {
    pg8::Gemm g; g.A = A; g.Bt = Bt; g.M = M; g.N = N; g.K = K;
    int c_ = obid() + crot; if (c_ >= (int)gridDim.x) c_ -= (int)gridDim.x;
    pg8::StaticOrder S; S.init(M, N, (int)gridDim.x, c_);
    pg8::gemm_phase<Epi>((LAS unsigned char*)shm, g, S, E);
}

template <int MODE>
__device__ __forceinline__ int wsrc(int r) {
    if (MODE == 0) return r;
    if (MODE == 1) { const int pn = r >> 8, bj = (r >> 7) & 1, i = r & 127; return bj * DFF + 128 * pn + i; }
    if (r < 2048) return r; if (r < 6144) return r + 1024; if (r < 10240) return r + 1040; if (r < 10256) return r - 10240 + 7168; if (r < 10496) return -1; return r - 10496 + 2048;
}
template <int MODE>
__device__ void convert_w(const float* W, int K, int N, bf16_t* Bt, int rows_out, unsigned char* shm, int bid, int nblk) {
    float* tile = (float*)shm;
    const int tid = otid(), nkt = K / 256, ntiles = (rows_out / 64) * nkt;
    const int nn = tid & 63, kk0 = tid >> 6;
    float pre[32];
#define CW_LOAD(tt) do { const int r0_ = ((tt) / nkt) * 64, k0_ = ((tt) % nkt) * 256; const int src_ = wsrc<MODE>(r0_ + nn); \
        const float* wp_ = W + (size_t)(k0_ + kk0) * N + (src_ < 0 ? 0 : src_); \
        _Pragma("unroll") for (int i = 0; i < 32; ++i) { const float v_ = wp_[(size_t)(8 * i) * N]; pre[i] = src_ < 0 ? 0.f : v_; } } while (0)
    int t = bid;
    if (t < ntiles) CW_LOAD(t);
    for (; t < ntiles; t += nblk) {
        const int r0 = (t / nkt) * 64, k0 = (t % nkt) * 256;
#pragma unroll
        for (int i = 0; i < 32; ++i) tile[(kk0 + 8 * i) * 65 + nn] = pre[i];
        __syncthreads();
        if (t + nblk < ntiles) CW_LOAD(t + nblk);
#pragma unroll
        for (int q = 0; q < 4; ++q) { const int id = tid + 512 * q, n2 = id >> 5, kc = (id & 31) * 8; float v[8];
#pragma unroll
            for (int j = 0; j < 8; ++j) v[j] = tile[(kc + j) * 65 + n2];
            u32x4 w; w.x = pk2(v[0], v[1]); w.y = pk2(v[2], v[3]); w.z = pk2(v[4], v[5]); w.w = pk2(v[6], v[7]);
            *(u32x4*)(Bt + (size_t)(r0 + n2) * K + k0 + kc) = w; }
        __syncthreads();
    }
#undef CW_LOAD
}

__device__ void convert_x(const float* x, bf16_t* xb, size_t n) {
    const size_t n8 = n / 8;
    for (size_t i = (size_t)obid() * 512 + otid(); i < n8; i += (size_t)gridDim.x * 512) {
        const f32x4 a = *(const f32x4*)(x + i * 8), b = *(const f32x4*)(x + i * 8 + 4);
        u32x4 w; w.x = pk2(a[0], a[1]); w.y = pk2(a[2], a[3]); w.z = pk2(b[0], b[1]); w.w = pk2(b[2], b[3]);
        *(u32x4*)(xb + i * 8) = w;
    }
}

__device__ __forceinline__ float wave_sum(float v) {
#pragma unroll
    for (int o = 32; o >= 1; o >>= 1) v += __shfl_xor(v, o);
    return v;
}
__device__ __forceinline__ float wave_max(float v) {
#pragma unroll
    for (int o = 32; o >= 1; o >>= 1) v = fmaxf(v, __shfl_xor(v, o));
    return v;
}

__device__ void ln_phase(const bf16_t* X, const float* g, const float* b, bf16_t* xb, float* fout, int rows, float* stats) {
    const int tid_ = otid(); const int lane = tid_ & 63, wv = obid() * 8 + (tid_ >> 6), nw = gridDim.x * 8;
    for (int row0 = wv; row0 < rows; row0 += 2 * nw) {
        const int row1 = row0 + nw; const bool has1 = row1 < rows; const int r1 = has1 ? row1 : row0;
        u32x4 nx[2][4];
#pragma unroll
        for (int i = 0; i < 4; ++i) { nx[0][i] = *(const u32x4*)(X + (size_t)row0 * DM + i * 512 + lane * 8); nx[1][i] = *(const u32x4*)(X + (size_t)r1 * DM + i * 512 + lane * 8); }
        f32x4 v[2][8]; float s[2], q[2];
#pragma unroll
        for (int k = 0; k < 2; ++k) { s[k] = 0.f;
#pragma unroll
            for (int i = 0; i < 4; ++i) { const u32x4 x4 = nx[k][i];
                v[k][2 * i] = (f32x4){hlo(x4.x), hhi(x4.x), hlo(x4.y), hhi(x4.y)}; v[k][2 * i + 1] = (f32x4){hlo(x4.z), hhi(x4.z), hlo(x4.w), hhi(x4.w)};
                s[k] += ((v[k][2 * i][0] + v[k][2 * i][1]) + (v[k][2 * i][2] + v[k][2 * i][3])) + ((v[k][2 * i + 1][0] + v[k][2 * i + 1][1]) + (v[k][2 * i + 1][2] + v[k][2 * i + 1][3])); } }
#pragma unroll
        for (int o = 32; o >= 1; o >>= 1) { s[0] += __shfl_xor(s[0], o); s[1] += __shfl_xor(s[1], o); }
#pragma unroll
        for (int k = 0; k < 2; ++k) { const float mu = s[k] * (1.0f / DM); s[k] = mu; q[k] = 0.f;
#pragma unroll
            for (int i = 0; i < 8; ++i) { v[k][i] = v[k][i] - mu; q[k] += (v[k][i][0] * v[k][i][0] + v[k][i][1] * v[k][i][1]) + (v[k][i][2] * v[k][i][2] + v[k][i][3] * v[k][i][3]); } }
#pragma unroll
        for (int o = 32; o >= 1; o >>= 1) { q[0] += __shfl_xor(q[0], o); q[1] += __shfl_xor(q[1], o); }
#pragma unroll
        for (int k = 0; k < 2; ++k) { if (k == 1 && !has1) break;
            const int row = k ? row1 : row0; const float rstd = rsqrtf(q[k] * (1.0f / DM) + LN_EPS);
            if (stats && lane == 0) { stats[(size_t)row * 2] = s[k]; stats[(size_t)row * 2 + 1] = rstd; }
#pragma unroll
            for (int i = 0; i < 4; ++i) { const int c = i * 512 + lane * 8;
                const f32x4 g0 = *(const f32x4*)(g + c), g1 = *(const f32x4*)(g + c + 4), b0 = *(const f32x4*)(b + c), b1 = *(const f32x4*)(b + c + 4);
                const f32x4 y0 = v[k][2 * i] * rstd * g0 + b0, y1 = v[k][2 * i + 1] * rstd * g1 + b1;
                if (fout) { *(f32x4*)(fout + (size_t)row * DM + c) = y0; *(f32x4*)(fout + (size_t)row * DM + c + 4) = y1; }
                if (xb) { u32x4 w; w.x = pk2(y0[0], y0[1]); w.y = pk2(y0[2], y0[3]); w.z = pk2(y1[0], y1[1]); w.w = pk2(y1[2], y1[3]); *(u32x4*)(xb + (size_t)row * DM + c) = w; } } }
    }
}

__device__ void conv_phase(const bf16_t* zqk, const float* cw, const float* cb, bf16_t* qk, int half) {
    const int total = (TH / 4) * 256;
    for (int idx = obid() * 512 + otid(); idx < total; idx += gridDim.x * 512) {
        const int t4 = (idx >> 8) * 4, c8 = (idx & 255) * 8;
        int s0, s1;
        if (half == 0) { if (t4 < 8192) { s0 = 0; s1 = 8192; } else { s0 = 8192 + ((t4 - 8192) >> 12) * 4096; s1 = s0 + 4096; } }
        else { s0 = (t4 >> 12) * 4096; s1 = s0 + 4096; }
        float w[5][8], bia[8];
#pragma unroll
        for (int j = 0; j < 5; ++j) { const f32x4 w0 = *(const f32x4*)(cw + j * 2048 + c8), w1 = *(const f32x4*)(cw + j * 2048 + c8 + 4);
            w[j][0] = w0[0]; w[j][1] = w0[1]; w[j][2] = w0[2]; w[j][3] = w0[3]; w[j][4] = w1[0]; w[j][5] = w1[1]; w[j][6] = w1[2]; w[j][7] = w1[3]; }
        { const f32x4 b0 = *(const f32x4*)(cb + c8), b1 = *(const f32x4*)(cb + c8 + 4);
          bia[0] = b0[0]; bia[1] = b0[1]; bia[2] = b0[2]; bia[3] = b0[3]; bia[4] = b1[0]; bia[5] = b1[1]; bia[6] = b1[2]; bia[7] = b1[3]; }
        u32x4 r[8];
#pragma unroll
        for (int i = 0; i < 8; ++i) { const int tt = t4 - 2 + i; r[i] = (tt >= s0 && tt < s1) ? *(const u32x4*)(zqk + (size_t)tt * 2048 + c8) : (u32x4){0u, 0u, 0u, 0u}; }
        const float sc = c8 >= 1024 ? 0.0625f : 1.0f;
#pragma unroll
        for (int o = 0; o < 4; ++o) { float a[8];
#pragma unroll
            for (int q = 0; q < 8; ++q) a[q] = bia[q];
#pragma unroll
            for (int j = 0; j < 5; ++j) { const u32x4 x = r[o + j];
                a[0] += w[j][0] * bflo(x.x); a[1] += w[j][1] * bfhi(x.x); a[2] += w[j][2] * bflo(x.y); a[3] += w[j][3] * bfhi(x.y);
                a[4] += w[j][4] * bflo(x.z); a[5] += w[j][5] * bfhi(x.z); a[6] += w[j][6] * bflo(x.w); a[7] += w[j][7] * bfhi(x.w); }
#pragma unroll
            for (int q = 0; q < 8; ++q) a[q] = a[q] * sigmoidf_(a[q]) * sc;
            u32x4 wv; wv.x = pk2(a[0], a[1]); wv.y = pk2(a[2], a[3]); wv.z = pk2(a[4], a[5]); wv.w = pk2(a[6], a[7]);
            *(u32x4*)(qk + (size_t)(t4 + o) * 2048 + c8) = wv; }
    }
}

__device__ void gates_phase(const bf16_t* xbh  , const bf16_t* wg  , float* gates  ) {
    const int tid = otid(), lane = tid & 63, fr = lane & 15, fq = lane >> 4;
    for (int item = obid() * 8 + (tid >> 6); item < TH / 16; item += gridDim.x * 8) {
        const bf16_t* ap = xbh + (size_t)(item * 16 + fr) * DM + fq * 8;
        const bf16_t* bp = wg + (size_t)fr * DM + fq * 8;
        f32x4 acc0 = (f32x4){0.f, 0.f, 0.f, 0.f}, acc1 = (f32x4){0.f, 0.f, 0.f, 0.f};
#pragma unroll 8
        for (int kk = 0; kk < 64; kk += 2) {
            acc0 = __builtin_amdgcn_mfma_f32_16x16x32_bf16(*(const bf16x8*)(ap + kk * 32), *(const bf16x8*)(bp + kk * 32), acc0, 0, 0, 0);
            acc1 = __builtin_amdgcn_mfma_f32_16x16x32_bf16(*(const bf16x8*)(ap + kk * 32 + 32), *(const bf16x8*)(bp + kk * 32 + 32), acc1, 0, 0, 0); }
#pragma unroll
        for (int j = 0; j < 4; ++j) gates[(size_t)(item * 16 + fq * 4 + j) * 16 + fr] = acc0[j] + acc1[j];
    }
}

__device__ void na_phase(const bf16_t* zna  , const bf16_t* vtn  , const float* rpb, bf16_t* ya, int half, unsigned* counter) {
    const int tid = otid(), lane = tid & 63, fr = lane & 15, fq = lane >> 4;
    constexpr int NPH = (TH / 64) * 4;
    int hq = 0;
    for (;;) {
        int item = -1;
        if (lane == 0) { while (hq < 8) { const int hh = (obid() + hq) & 7; const unsigned v = atomicAdd(counter + hh * 16, 1u); if (v < (unsigned)NPH) { item = hh * NPH + (int)v; break; } ++hq; } }
        item = __builtin_amdgcn_readfirstlane(item); hq = __builtin_amdgcn_readfirstlane(hq);
        if (item < 0) break;
        const int h = item / NPH, rem = item - h * NPH, cbk = rem & 3, rowidx = rem >> 2;
        int seqrow0, rows;
        if (half == 0) { if (rowidx < 128) { seqrow0 = 0; rows = 128; } else { seqrow0 = 128 + ((rowidx - 128) >> 6) * 64; rows = 64; } }
        else { seqrow0 = (rowidx >> 6) * 64; rows = 64; }
        const int r = rowidx - seqrow0;
        const int rs = min(max(r - 4, 0), rows - 8);
        const int kstart = min(max(cbk * 16 - 8, 0), 32);
        const int krow0 = seqrow0 + rs;
        bf16x8 qf[4];
        { const bf16_t* qp = zna + (size_t)(rowidx * 64 + cbk * 16 + fr) * 2048 + h * 128 + fq * 8;
#pragma unroll
          for (int kk = 0; kk < 4; ++kk) qf[kk] = *(const bf16x8*)(qp + kk * 32); }
        f32x4 s[16];
        const int jperm = 8 * (fr >> 2) + (fr & 3);
#pragma unroll
        for (int a = 0; a < 8; ++a)
#pragma unroll
            for (int u = 0; u < 2; ++u) {
                const bf16_t* kp = zna + (size_t)((krow0 + a) * 64 + kstart + jperm + 4 * u) * 2048 + 1024 + h * 128 + fq * 8;
                f32x4 acc = (f32x4){0.f, 0.f, 0.f, 0.f};
#pragma unroll
                for (int kk = 0; kk < 4; ++kk) acc = __builtin_amdgcn_mfma_f32_16x16x32_bf16(*(const bf16x8*)(kp + kk * 32), qf[kk], acc, 0, 0, 0);
                s[a * 2 + u] = acc;
            }
        const int c = cbk * 16 + fr, wsx = min(max(c - 8, 0), 48);
        const float* bp = rpb + (h * 15 + (rs - r + 7)) * 31;
        float mx = -INFINITY;
#pragma unroll
        for (int a = 0; a < 8; ++a)
#pragma unroll
            for (int u = 0; u < 2; ++u)
#pragma unroll
                for (int j = 0; j < 4; ++j) { const int kc = kstart + 8 * fq + 4 * u + j; const bool valid = (kc >= wsx) && (kc < wsx + 16);
                    const int ci = min(max(kc - c + 15, 0), 30);
                    const float v = valid ? s[a * 2 + u][j] * 0.08838834764831845f + bp[a * 31 + ci] : -INFINITY;
                    s[a * 2 + u][j] = v; mx = fmaxf(mx, v); }
        mx = fmaxf(mx, __shfl_xor(mx, 16)); mx = fmaxf(mx, __shfl_xor(mx, 32));
        float sm = 0.f;
#pragma unroll
        for (int t = 0; t < 16; ++t)
#pragma unroll
            for (int j = 0; j < 4; ++j) { const float e = __expf(s[t][j] - mx); s[t][j] = e; sm += e; }
        sm += __shfl_xor(sm, 16); sm += __shfl_xor(sm, 32);
        f32x4 o[8];
#pragma unroll
        for (int dt = 0; dt < 8; ++dt) o[dt] = (f32x4){0.f, 0.f, 0.f, 0.f};
        const bf16_t* vb = vtn + (size_t)(h * 128 + fr) * TH + (size_t)krow0 * 64 + kstart + fq * 8;
#pragma unroll
        for (int a = 0; a < 8; ++a) {
            const u32x4 pw = (u32x4){pk2(s[2 * a][0], s[2 * a][1]), pk2(s[2 * a][2], s[2 * a][3]), pk2(s[2 * a + 1][0], s[2 * a + 1][1]), pk2(s[2 * a + 1][2], s[2 * a + 1][3])};
            const bf16x8 pf = *(const bf16x8*)&pw;
#pragma unroll
            for (int dt = 0; dt < 8; ++dt) { const bf16x8 vf = *(const bf16x8*)(vb + (size_t)dt * 16 * TH + a * 64);
                o[dt] = __builtin_amdgcn_mfma_f32_16x16x32_bf16(vf, pf, o[dt], 0, 0, 0); }
        }
        const float inv = 1.0f / sm;
        bf16_t* op = ya + (size_t)(rowidx * 64 + cbk * 16 + fr) * 1024 + h * 128 + fq * 4;
#pragma unroll
        for (int dt = 0; dt < 8; ++dt) { u32x2 w; w.x = pk2(o[dt][0] * inv, o[dt][1] * inv); w.y = pk2(o[dt][2] * inv, o[dt][3] * inv); *(u32x2*)(op + dt * 16) = w; }
    }
}

constexpr int ML_QS = 0, ML_KS = 33792, ML_VT = 67584, ML_CT = 79104, ML_VEC = 121344;
constexpr int ML_EP = 80, ML_HSLD = 68, ML_HS = 124416, ML_SC = ML_HS + 64 * ML_HSLD * 4, ML_VTW = ML_SC + 64 * 72 * 2;
static_assert(ML_VTW + ML_EP * 72 * 2 <= LDS_BYTES - 16, "mLSTM LDS layout fits");
__device__ void mlstm_phase(const bf16_t* qk, const bf16_t* vo, const float* gates, const float* gate_b, bf16_t* hf, bf16_t* hb, unsigned char* shm) {
    bf16_t* Qs = (bf16_t*)(shm + ML_QS); bf16_t* Ks = (bf16_t*)(shm + ML_KS); bf16_t* VT = (bf16_t*)(shm + ML_VT); bf16_t* CT = (bf16_t*)(shm + ML_CT);
    float* HS = (float*)(shm + ML_HS); bf16_t* SC = (bf16_t*)(shm + ML_SC); bf16_t* VTW = (bf16_t*)(shm + ML_VTW);
    const int tid = otid(), lane = tid & 63, wid = __builtin_amdgcn_readfirstlane(tid >> 6), fr = lane & 15, fq = lane >> 4;
    const int G_ = (int)gridDim.x, bid_ = obid();
    for (int k_ = 0; k_ < 2; ++k_) {
        const int item = k_ == 0 ? bid_ : (G_ == 256 ? ((bid_ >= 32 && bid_ < 64) ? 224 + bid_ : 288) : bid_ + G_);
        if (item >= 288) break;
        const int sq = item < 32 ? 0 : 1 + ((item - 32) >> 5), rem = item < 32 ? item : ((item - 32) & 31), dh = rem >> 2, sl = rem & 3, dir = dh >> 2, h = dh & 3;
        int tokbase, N;
        if (sq == 0) { tokbase = 0; N = 8192; } else { tokbase = 8192 + (sq - 1) * 4096; N = 4096; }
        const int nchunks = N >> 6;
        bf16_t* hout = dir ? hb : hf;
        for (int i = tid; i < 80 * 264 / 2; i += 512) ((unsigned*)CT)[i] = 0u;
        for (int i = tid; i < 16 * 72; i += 512) VT[64 * 72 + i] = (i < 72) ? (bf16_t)0x3F80 : (bf16_t)0;
        for (int i = tid; i < 16 * 72; i += 512) VTW[64 * 72 + i] = (bf16_t)0;
        f32x4 state[2][5];
#pragma unroll
        for (int a = 0; a < 2; ++a)
#pragma unroll
            for (int b = 0; b < 5; ++b) state[a][b] = (f32x4){0.f, 0.f, 0.f, 0.f};
        float mcar = 0.f;
        const int sgn = dir ? -1 : 1;
        const float gbi = gate_b[dir * 4 + h], gbf = gate_b[8 + dir * 4 + h];
        u32x4 qreg[4], kreg[4], vreg; float ipre = 0.f, fpre = 0.f;
#define ML_LOAD(cc) do { const int cb_ = dir ? (tokbase + N - 1 - 64 * (cc)) : (tokbase + 64 * (cc)); \
            _Pragma("unroll") for (int i = 0; i < 4; ++i) { const int id = tid + 512 * i, row = id >> 5, c8 = (id & 31) * 8; \
                const bf16_t* p_ = qk + (size_t)(cb_ + sgn * row) * 2048 + h * 256 + c8; qreg[i] = *(const u32x4*)p_; kreg[i] = *(const u32x4*)(p_ + 1024); } \
            { const int row = tid >> 3, c8 = (tid & 7) * 8; vreg = *(const u32x4*)(vo + (size_t)(cb_ + sgn * row) * 2048 + h * 256 + sl * 64 + c8); } \
            } while (0)
#define ML_GLOAD(cc) do { const int cb_ = dir ? (tokbase + N - 1 - 64 * (cc)) : (tokbase + 64 * (cc)); const size_t tk = (size_t)(cb_ + sgn * lane); \
            ipre = gates[tk * 16 + dir * 4 + h]; fpre = gates[tk * 16 + 8 + dir * 4 + h]; } while (0)
        ML_LOAD(0);
        u32x4 pendw = (u32x4){0u, 0u, 0u, 0u}; bf16_t* pend_p = hout;
#define ML_GATES(cc) do { float* vec_ = (float*)(shm + ML_VEC) + ((cc) & 1) * 328; \
            const float ip = ipre + gbi, fp = fpre + gbf; \
            const float lf = fminf(fp, 0.f) - log1pf(__expf(-fabsf(fp))); \
            float b = lf; \
            _Pragma("unroll") for (int o = 1; o < 64; o <<= 1) { const float t = __shfl_up(b, o); if (lane >= o) b += t; } \
            const float colv = ip - b; float pm = colv; \
            _Pragma("unroll") for (int o = 1; o < 64; o <<= 1) { const float t = __shfl_up(pm, o); if (lane >= o) pm = fmaxf(pm, t); } \
            const float mm = fmaxf(mcar, pm); const float blast = __shfl(b, 63), pm63 = __shfl(pm, 63); const float mm63 = fmaxf(mcar, pm63); \
            vec_[lane] = -mm; vec_[64 + lane] = colv; vec_[128 + lane] = __expf(mcar - mm); vec_[192 + lane] = __expf(-(b + mm)); \
            vec_[256 + lane] = __expf(colv - mm63); if (lane == 0) vec_[320] = __expf(mcar - mm63); \
            mcar = blast + mm63; } while (0)
        if (wid == 4) { ML_GLOAD(0); ML_GATES(0); if (nchunks > 1) ML_GLOAD(1); }
        __syncthreads();
        for (int c = 0; c < nchunks; ++c) {
            float* vec = (float*)(shm + ML_VEC) + (c & 1) * 328;
            const int cbase = dir ? (tokbase + N - 1 - 64 * c) : (tokbase + 64 * c);
#pragma unroll
            for (int i = 0; i < 4; ++i) { const int id = tid + 512 * i, row = id >> 5, c8 = (id & 31) * 8;
                *(u32x4*)(Qs + row * 264 + c8) = qreg[i]; *(u32x4*)(Ks + row * 264 + c8) = kreg[i]; }
            { const int row = tid >> 3, c8 = (tid & 7) * 8;
              VT[(c8 + 0) * 72 + row] = (bf16_t)(vreg.x & 0xffff); VT[(c8 + 1) * 72 + row] = (bf16_t)(vreg.x >> 16);
              VT[(c8 + 2) * 72 + row] = (bf16_t)(vreg.y & 0xffff); VT[(c8 + 3) * 72 + row] = (bf16_t)(vreg.y >> 16);
              VT[(c8 + 4) * 72 + row] = (bf16_t)(vreg.z & 0xffff); VT[(c8 + 5) * 72 + row] = (bf16_t)(vreg.z >> 16);
              VT[(c8 + 6) * 72 + row] = (bf16_t)(vreg.w & 0xffff); VT[(c8 + 7) * 72 + row] = (bf16_t)(vreg.w >> 16); }
            { const int row = tid >> 3, c8 = (tid & 7) * 8; const float wr_ = vec[256 + row];
              const unsigned q0 = pk2(bflo(vreg.x) * wr_, bfhi(vreg.x) * wr_), q1 = pk2(bflo(vreg.y) * wr_, bfhi(vreg.y) * wr_), q2 = pk2(bflo(vreg.z) * wr_, bfhi(vreg.z) * wr_), q3 = pk2(bflo(vreg.w) * wr_, bfhi(vreg.w) * wr_);
              VTW[(c8 + 0) * 72 + row] = (bf16_t)(q0 & 0xffff); VTW[(c8 + 1) * 72 + row] = (bf16_t)(q0 >> 16);
              VTW[(c8 + 2) * 72 + row] = (bf16_t)(q1 & 0xffff); VTW[(c8 + 3) * 72 + row] = (bf16_t)(q1 >> 16);
              VTW[(c8 + 4) * 72 + row] = (bf16_t)(q2 & 0xffff); VTW[(c8 + 5) * 72 + row] = (bf16_t)(q2 >> 16);
              VTW[(c8 + 6) * 72 + row] = (bf16_t)(q3 & 0xffff); VTW[(c8 + 7) * 72 + row] = (bf16_t)(q3 >> 16);
              if (tid < 64) VTW[64 * 72 + tid] = f2bf(vec[256 + tid]); }
            asm volatile("" ::: "memory");
            if (c > 0) *(u32x4*)pend_p = pendw;
            if (c + 1 < nchunks) ML_LOAD(c + 1);
            __syncthreads();
            const int tt = wid & 3, hf2 = wid >> 2;
            bf16x8 qf[8];
#pragma unroll
            for (int kk = 0; kk < 8; ++kk) qf[kk] = *(const bf16x8*)(Qs + (tt * 16 + fr) * 264 + kk * 32 + fq * 8);
#pragma unroll
            for (int q2 = 0; q2 < 2; ++q2) { const int st = hf2 * 2 + q2; f32x4 acc = (f32x4){0.f, 0.f, 0.f, 0.f};
                if (st <= tt) {
#pragma unroll
                    for (int kk = 0; kk < 8; ++kk) { const bf16x8 b = *(const bf16x8*)(Ks + (st * 16 + fr) * 264 + kk * 32 + fq * 8);
                        acc = __builtin_amdgcn_mfma_f32_16x16x32_bf16(qf[kk], b, acc, 0, 0, 0); } }
                const int s = st * 16 + fr; const float cv = vec[64 + s];
                float sv[4];
#pragma unroll
                for (int j = 0; j < 4; ++j) { const int t = tt * 16 + fq * 4 + j; sv[j] = (s <= t) ? acc[j] * __expf(vec[t] + cv) : 0.f; }
                const unsigned w01 = pk2(sv[0], sv[1]), w23 = pk2(sv[2], sv[3]);
                bf16_t* scp = SC + (tt * 16 + fq * 4) * 72 + s;
                scp[0] = (bf16_t)(w01 & 0xffff); scp[72] = (bf16_t)(w01 >> 16); scp[144] = (bf16_t)(w23 & 0xffff); scp[216] = (bf16_t)(w23 >> 16); }
            { const float decay = vec[320];
#pragma unroll
              for (int dt = 0; dt < 2; ++dt)
#pragma unroll
                  for (int et = 0; et < 5; ++et) state[dt][et] = state[dt][et] * decay;
              { u32x2 r000, r001, r010, r011, r100, r101, r110, r111;
                const unsigned kaddr = (unsigned)(size_t)(LAS unsigned char*)shm + ML_KS + (unsigned)(((fq * 8 + (fr >> 2)) * 264 + wid * 32 + 4 * (fr & 3)) * 2);
                asm volatile("ds_read_b64_tr_b16 %0, %8\n\tds_read_b64_tr_b16 %1, %8 offset:32\n\tds_read_b64_tr_b16 %2, %8 offset:2112\n\tds_read_b64_tr_b16 %3, %8 offset:2144\n\t"
                             "ds_read_b64_tr_b16 %4, %8 offset:16896\n\tds_read_b64_tr_b16 %5, %8 offset:16928\n\tds_read_b64_tr_b16 %6, %8 offset:19008\n\tds_read_b64_tr_b16 %7, %8 offset:19040\n\t"
                             "s_waitcnt lgkmcnt(0)"
                             : "=&v"(r000), "=&v"(r001), "=&v"(r010), "=&v"(r011), "=&v"(r100), "=&v"(r101), "=&v"(r110), "=&v"(r111) : "v"(kaddr) : "memory");
                bf16x8 a[2][2];
                { const u32x4 t0 = (u32x4){r000.x, r000.y, r010.x, r010.y}; a[0][0] = *(const bf16x8*)&t0; const u32x4 t1 = (u32x4){r001.x, r001.y, r011.x, r011.y}; a[0][1] = *(const bf16x8*)&t1;
                  const u32x4 t2 = (u32x4){r100.x, r100.y, r110.x, r110.y}; a[1][0] = *(const bf16x8*)&t2; const u32x4 t3 = (u32x4){r101.x, r101.y, r111.x, r111.y}; a[1][1] = *(const bf16x8*)&t3; }
#pragma unroll
                for (int kk = 0; kk < 2; ++kk)
#pragma unroll
                  for (int et = 0; et < 5; ++et) { const bf16x8 b = *(const bf16x8*)(VTW + (et * 16 + fr) * 72 + kk * 32 + fq * 8);
#pragma unroll
                      for (int dt = 0; dt < 2; ++dt) state[dt][et] = __builtin_amdgcn_mfma_f32_16x16x32_bf16(a[kk][dt], b, state[dt][et], 0, 0, 0); } } }
            if (wid == 4 && c + 1 < nchunks) { ML_GATES(c + 1); if (c + 2 < nchunks) ML_GLOAD(c + 2); }
            __syncthreads();
            { const int et0 = hf2 ? 3 : 0, net = hf2 ? 2 : 3;
              bf16x8 scf[2];
#pragma unroll
              for (int kk = 0; kk < 2; ++kk) scf[kk] = *(const bf16x8*)(SC + (tt * 16 + fr) * 72 + kk * 32 + fq * 8);
              const f32x4 ain = *(const f32x4*)(vec + 128 + tt * 16 + fq * 4);
#pragma unroll
              for (int e = 0; e < 3; ++e) { if (e < net) { const int et = et0 + e; f32x4 acc = (f32x4){0.f, 0.f, 0.f, 0.f};
#pragma unroll
                  for (int kk = 0; kk < 8; ++kk) { const bf16x8 b = *(const bf16x8*)(CT + (et * 16 + fr) * 264 + kk * 32 + fq * 8);
                      acc = __builtin_amdgcn_mfma_f32_16x16x32_bf16(qf[kk], b, acc, 0, 0, 0); }
                  acc = acc * ain;
#pragma unroll
                  for (int kk = 0; kk < 2; ++kk) { const bf16x8 b = *(const bf16x8*)(VT + (et * 16 + fr) * 72 + kk * 32 + fq * 8);
                      acc = __builtin_amdgcn_mfma_f32_16x16x32_bf16(scf[kk], b, acc, 0, 0, 0); }
                  if (et < 4 || fr == 0) {
#pragma unroll
                      for (int j = 0; j < 4; ++j) HS[(tt * 16 + fq * 4 + j) * ML_HSLD + et * 16 + fr] = acc[j]; } } } }
            __syncthreads();
#pragma unroll
            for (int dt = 0; dt < 2; ++dt) { const int d0 = (wid * 2 + dt) * 16 + fq * 4;
#pragma unroll
                for (int et = 0; et < 5; ++et) { u32x2 w; w.x = pk2(state[dt][et][0], state[dt][et][1]); w.y = pk2(state[dt][et][2], state[dt][et][3]);
                    *(u32x2*)(CT + (et * 16 + fr) * 264 + d0) = w; } }
            { const int t = tid >> 3, ec = (tid & 7) * 8;
              const float den = HS[t * ML_HSLD + 64]; const float dn = fmaxf(fabsf(den), vec[192 + t]); const float inv = __builtin_amdgcn_rcpf(dn);
              const f32x4 n0 = *(const f32x4*)(HS + t * ML_HSLD + ec), n1 = *(const f32x4*)(HS + t * ML_HSLD + ec + 4);
              pend_p = hout + (size_t)(cbase + sgn * t) * 1024 + h * 256 + sl * 64 + ec;
              pendw.x = pk2(n0[0] * inv, n0[1] * inv); pendw.y = pk2(n0[2] * inv, n0[3] * inv); pendw.z = pk2(n1[0] * inv, n1[1] * inv); pendw.w = pk2(n1[2] * inv, n1[3] * inv); }
        }
        *(u32x4*)pend_p = pendw;
        __syncthreads();
    }
#undef ML_LOAD
#undef ML_GLOAD
#undef ML_GATES
}

__device__ void mlnorm_phase(const bf16_t* hf, const bf16_t* hb, const float* ng, const bf16_t* vo, bf16_t* ym) {
    const int tid_ = otid(); const int lane = tid_ & 63, wv = obid() * 8 + (tid_ >> 6), nw = gridDim.x * 8;
    f32x4 gg[4];
#pragma unroll
    for (int h = 0; h < 4; ++h) gg[h] = *(const f32x4*)(ng + h * 256 + lane * 4);
    for (int t = wv; t < TH; t += nw) {
        u32x2 ha[4], hc[4], ow[4];
#pragma unroll
        for (int h = 0; h < 4; ++h) { const int c = h * 256 + lane * 4; const size_t ix = (size_t)t * 1024 + c;
            ha[h] = *(const u32x2*)(hf + ix); hc[h] = *(const u32x2*)(hb + ix); ow[h] = *(const u32x2*)(vo + (size_t)t * 2048 + 1024 + c); }
        f32x4 v[4]; float s[4], q[4];
#pragma unroll
        for (int h = 0; h < 4; ++h) { v[h] = (f32x4){bflo(ha[h].x) + bflo(hc[h].x), bfhi(ha[h].x) + bfhi(hc[h].x), bflo(ha[h].y) + bflo(hc[h].y), bfhi(ha[h].y) + bfhi(hc[h].y)};
            s[h] = (v[h][0] + v[h][1]) + (v[h][2] + v[h][3]); }
#pragma unroll
        for (int o = 32; o >= 1; o >>= 1)
#pragma unroll
            for (int h = 0; h < 4; ++h) s[h] += __shfl_xor(s[h], o);
#pragma unroll
        for (int h = 0; h < 4; ++h) { v[h] = v[h] - s[h] * (1.0f / 256.0f); q[h] = (v[h][0] * v[h][0] + v[h][1] * v[h][1]) + (v[h][2] * v[h][2] + v[h][3] * v[h][3]); }
#pragma unroll
        for (int o = 32; o >= 1; o >>= 1)
#pragma unroll
            for (int h = 0; h < 4; ++h) q[h] += __shfl_xor(q[h], o);
#pragma unroll
        for (int h = 0; h < 4; ++h) { const float rstd = rsqrtf(q[h] * (1.0f / 256.0f) + LN_EPS);
            const float y0 = v[h][0] * rstd * gg[h][0] * bflo(ow[h].x), y1 = v[h][1] * rstd * gg[h][1] * bfhi(ow[h].x), y2 = v[h][2] * rstd * gg[h][2] * bflo(ow[h].y), y3 = v[h][3] * rstd * gg[h][3] * bfhi(ow[h].y);
            u32x2 w; w.x = pk2(y0, y1); w.y = pk2(y2, y3);
            *(u32x2*)(ym + (size_t)t * 1024 + h * 256 + lane * 4) = w; }
    }
}


#define XB_TMO      128
#define XB_XCNT(j)  (256  + 64 * (j))
#define XB_XSUB(j)  (1280 + 64 * (j))
#define XB_XGEN(j)  (2304 + 64 * (j))
#define XB_TOP      3328
#define XB_TOPGEN   3392
#define XCD_BAR_WORDS 3456
#define XB_SPIN_CAP (1u << 20)
__device__ __forceinline__ unsigned xb_ld(unsigned* p)              { return __hip_atomic_load(p, __ATOMIC_RELAXED, __HIP_MEMORY_SCOPE_AGENT); }
__device__ __forceinline__ unsigned xb_add(unsigned* p, unsigned v) { return __hip_atomic_fetch_add(p, v, __ATOMIC_RELAXED, __HIP_MEMORY_SCOPE_AGENT); }
__device__ __forceinline__ unsigned xb_xcc_id() { return (unsigned)__builtin_amdgcn_s_getreg((3 << 11) | 20) & 0xFu; }
#define XB_SPIN(cond, bar) do { unsigned _sp = 0; while (cond) { __builtin_amdgcn_s_sleep(1); \
    if ((++_sp & 255u) == 0u) { if (xb_ld(&(bar)[XB_TMO])) break; if (_sp > XB_SPIN_CAP) { atomicAdd(&(bar)[XB_TMO], 1u); break; } } } } while (0)
__device__ __forceinline__ void xcd_barrier_post(unsigned* bar) { if (threadIdx.x == 0) (void)xb_add(&bar[XB_XCNT(xb_xcc_id())], 1u); }
__device__ __forceinline__ void xcd_barrier_complete(unsigned* bar, unsigned x, unsigned& nloc, unsigned& nx) {
    const unsigned G = gridDim.x * gridDim.y * gridDim.z;
    unsigned sum, cnt, mine, sp = 0u;
    for (;;) {
        sum = 0u; cnt = 0u; mine = 0u;
#pragma unroll
        for (unsigned j = 0; j < 16; ++j) { const unsigned c = xb_ld(&bar[XB_XCNT(j)]); sum += c; cnt += (c > 0u) ? 1u : 0u; mine = (j == x) ? c : mine; }
        if (sum == G) break;
        __builtin_amdgcn_s_sleep(1);
        if ((++sp & 255u) == 0u) { if (xb_ld(&bar[XB_TMO])) break; if (sp > XB_SPIN_CAP) { atomicAdd(&bar[XB_TMO], 1u); break; } }
    }
    nloc = mine > 0u ? mine : 1u; nx = cnt > 0u ? cnt : 1u;
}
__device__ __forceinline__ void xcd_barrier(unsigned* bar, volatile LAS unsigned* st) {
    asm volatile("s_waitcnt vmcnt(0)" ::: "memory");
    __syncthreads();
    if (threadIdx.x == 0) {
        __builtin_amdgcn_s_waitcnt(0);
        const unsigned x = xb_xcc_id();
        unsigned nloc = st[0], nx = st[1];
        if (nloc == 0u) { xcd_barrier_complete(bar, x, nloc, nx); st[0] = nloc; st[1] = nx; }
        const unsigned old = xb_add(&bar[XB_XSUB(x)], 1u);
        const unsigned gen = old / nloc;
        if (old + 1u == (gen + 1u) * nloc) {
            __builtin_amdgcn_fence(__ATOMIC_RELEASE, "agent");
            asm volatile("s_waitcnt vmcnt(0)" ::: "memory");
            const unsigned og = xb_add(&bar[XB_TOP], 1u);
            const unsigned tg = og / nx;
            if (og + 1u == (tg + 1u) * nx) xb_add(&bar[XB_TOPGEN], 1u);
            else XB_SPIN(xb_ld(&bar[XB_TOPGEN]) == tg, bar);
            __builtin_amdgcn_fence(__ATOMIC_ACQUIRE, "agent");
            xb_add(&bar[XB_XGEN(x)], 1u);
            asm volatile("s_waitcnt vmcnt(0)" ::: "memory");
        } else {
            XB_SPIN(xb_ld(&bar[XB_XGEN(x)]) == gen, bar);
            __builtin_amdgcn_fence(__ATOMIC_ACQUIRE, "agent");
            asm volatile("s_waitcnt vmcnt(0)" ::: "memory");
        }
    }
    __syncthreads();
}

__global__ void __launch_bounds__(512, 2) mega(Params p) {
    extern __shared__ __attribute__((aligned(16))) unsigned char shm[];
    cg::grid_group grid = cg::this_grid();
    unsigned* bar = (unsigned*)(p.ws + OFF_BAR);
    volatile LAS unsigned* bst = (volatile LAS unsigned*)((LAS unsigned char*)shm + LDS_BYTES - 16);
    if (threadIdx.x == 0) { bst[0] = 0u; bst[1] = 0u; }
    __syncthreads();
    xcd_barrier_post(bar);
    for (int ph = 0; ph < 17; ++ph) {
        if (ph == 8) continue;
        unsigned char* ws = p.ws;
        float* out = p.out;
        bf16_t* xb = (bf16_t*)(ws + OFF_XB); bf16_t* Hb = (bf16_t*)(ws + OFF_H);
        int kind;
        if (ph == 0) kind = 0; else if (ph == 1 || ph == 14) kind = 1; else if (ph == 2 || ph == 12 || ph == 15) kind = 2; else if (ph == 3 || ph == 8 || ph == 13 || ph == 16) kind = 3;
        else if (ph == 4 || ph == 9) kind = 4; else if (ph == 5) kind = 5; else if (ph == 6) kind = 6; else if (ph == 7) kind = 7; else kind = 8;
        switch (kind) {
        case 0: {
            const int bid = obid(), nb = (int)gridDim.x;
            convert_w<1>(p.in[2], DM, 2 * DFF, (bf16_t*)(ws + OFF_WGU_A), 2 * DFF, shm, bid, nb);
            convert_w<2>(p.in[6], DM, 11280, (bf16_t*)(ws + OFF_WIN), NIN_PAD, shm, bid, nb);
            for (int i = 0; i < 4; ++i) {
                const float* W = i == 0 ? p.in[3] : i == 1 ? p.in[12] : i == 2 ? p.in[13] : p.in[14];
                const size_t off = i == 0 ? OFF_WDN_A : i == 1 ? OFF_WPA : i == 2 ? OFF_WPM : OFF_WOUT;
                const int K = i < 1 ? DFF : i < 3 ? 1024 : DM;
                convert_w<0>(W, K, DM, (bf16_t*)(ws + off), DM, shm, bid, nb);
            }
            convert_x(p.in[0], xb, (size_t)8192 * DM);
            convert_x(p.in[1], xb + (size_t)8192 * DM, (size_t)32768 * DM);
        } break;
        case 1: {
            EpiSwiglu E; E.H = Hb;
            run_gemm(shm, xb, (const bf16_t*)(ws + OFF_WGU_A), T_ALL, 2 * DFF, DM, E);
        } break;
        case 2: {
            bf16_t* sb = (bf16_t*)out;
            EpiResid E; const bf16_t* A; const bf16_t* Bt; int K;
            E.stats = nullptr; E.lg = nullptr; E.lb = nullptr; E.x_bf16 = ph == 2;
            if (ph == 2) { A = Hb; Bt = (const bf16_t*)(ws + OFF_WDN_A); K = DFF; E.xres = xb; E.out = sb; E.scale = 0.5f; }
            else if (ph == 15) { A = Hb; Bt = (const bf16_t*)(ws + OFF_WDN_B); K = DFF; E.xres = sb; E.out = xb; E.scale = 0.5f;
                E.stats = (const float*)(ws + OFF_STATS_M); E.lg = p.in[15]; E.lb = p.in[16]; }
            else { A = (const bf16_t*)(ws + OFF_ZNA); Bt = (const bf16_t*)(ws + OFF_WOUT); K = DM; E.xres = sb; E.out = sb; E.scale = 1.0f;
                E.stats = (const float*)(ws + OFF_STATS_A); E.lg = p.in[4]; E.lb = p.in[5]; }
            run_gemm(shm, A, Bt, T_ALL, DM, K, E);
        } break;
        case 3: {
            const int gi = (ph == 3 || ph == 8) ? 4 : ph == 13 ? 15 : 19;
            const bf16_t* X = ph == 16 ? (const bf16_t*)xb : (const bf16_t*)out;
            ln_phase(X, p.in[gi], p.in[gi + 1], ph == 16 ? nullptr : xb, ph == 16 ? out : nullptr, ph == 8 ? T_ALL / 2 : T_ALL,
                     (ph == 3 || ph == 8) ? (float*)(ws + OFF_STATS_A) : ph == 13 ? (float*)(ws + OFF_STATS_M) : nullptr);
        } break;
        case 4: {
            const int nparts = ph == 4 ? 2 : 1;
            for (int part = 0; part < nparts; ++part) {
                EpiInproj E; E.zna = (bf16_t*)(ws + OFF_ZNA); E.zqk = (bf16_t*)(ws + OFF_ZQK); E.vo = (bf16_t*)(ws + OFF_VO); E.g = (bf16_t*)(ws + OFF_G);
                const bf16_t* win = (const bf16_t*)(ws + OFF_WIN);
                E.vt = (ph == 4 && part) ? (bf16_t*)(ws + OFF_VTN) : nullptr; E.gmode = ph == 9;
                if (ph == 9) run_gemm(shm, xb, win + (size_t)6144 * DM, T_ALL, 4096, DM, E);
                else if (part == 0) run_gemm(shm, xb, win, T_ALL, 6144, DM, E);
                else { run_gemm(shm, win + (size_t)10496 * DM, xb, 1024, T_ALL, DM, E);
                    const int nfull = (4 * (T_ALL / 256)) % (int)gridDim.x;
                    if (nfull > 0 && obid() >= nfull) convert_w<0>(p.in[18], DFF, DM, (bf16_t*)(ws + OFF_WDN_B), DM, shm, obid() - nfull, (int)gridDim.x - nfull); }
            }
        } break;
        case 5: gates_phase(xb, (const bf16_t*)(ws + OFF_WIN) + (size_t)10240 * DM, (float*)(ws + OFF_GATES));
            conv_phase((const bf16_t*)(ws + OFF_ZQK), p.in[8], p.in[9], (bf16_t*)(ws + OFF_QK), 0);
            if (obid() == 0 && otid() < 8) *(unsigned*)(ws + OFF_CTR + 64 * otid()) = 0u;
            break;
        case 6: {
            const int bid = obid();
            mlstm_phase((const bf16_t*)(ws + OFF_QK), (const bf16_t*)(ws + OFF_VO), (const float*)(ws + OFF_GATES), p.in[10], (bf16_t*)(ws + OFF_HF), (bf16_t*)out + (size_t)T_ALL * DM, shm);
            if (bid >= 64) {
                convert_w<1>(p.in[17], DM, 2 * DFF, (bf16_t*)(ws + OFF_WGU_B), 2 * DFF, shm, bid - 64, (int)gridDim.x - 64);
                if ((4 * (T_ALL / 256)) % (int)gridDim.x == 0) convert_w<0>(p.in[18], DFF, DM, (bf16_t*)(ws + OFF_WDN_B), DM, shm, bid - 64, (int)gridDim.x - 64);
            }
            na_phase((const bf16_t*)(ws + OFF_ZNA), (const bf16_t*)(ws + OFF_VTN), p.in[7], (bf16_t*)(ws + OFF_ZQK), 0, (unsigned*)(ws + OFF_CTR));
        } break;
        case 7: mlnorm_phase((const bf16_t*)(ws + OFF_HF), (const bf16_t*)out + (size_t)T_ALL * DM, p.in[11], (const bf16_t*)(ws + OFF_VO), (bf16_t*)(ws + OFF_ZQK) + (size_t)TH * 1024); break;
        default: {
            const bool pm_ = ph == 11;
            EpiMerge E; E.gate = (const bf16_t*)(ws + OFF_G) + (pm_ ? 2048 : 0); E.merged = (bf16_t*)(ws + OFF_ZNA); E.accum = pm_;
            const bf16_t* A = (const bf16_t*)(ws + OFF_ZQK) + (pm_ ? (size_t)TH * 1024 : 0);
            run_gemm(shm, A, (const bf16_t*)(ws + (pm_ ? OFF_WPM : OFF_WPA)), T_ALL, DM, 1024, E);
        } break;
        }
        if (ph == 0) grid.sync();
        else if (ph != 16 && ph != 10) xcd_barrier(bar, bst);
    }
}

extern "C" void kernel_launch(void* const* d_in, const int* in_sizes, int n_in, void* d_out, int out_size, void* d_ws, size_t ws_size, hipStream_t stream) {
    static int grid_blocks = 0;
    if (grid_blocks == 0) {
        if (n_in != 21 || ws_size < ((size_t)1 << 30)) { fprintf(stderr, "kernel_launch: unexpected n_in %d / ws %zu\n", n_in, ws_size); grid_blocks = -1; return; }
        int dev = 0, cus = 0, per_cu = 0;
        hipGetDevice(&dev);
        hipDeviceGetAttribute(&cus, hipDeviceAttributeMultiprocessorCount, dev);
        if (hipFuncSetAttribute((const void*)mega, hipFuncAttributeMaxDynamicSharedMemorySize, LDS_BYTES) != hipSuccess) { fprintf(stderr, "kernel_launch: hipFuncSetAttribute failed\n"); grid_blocks = -1; return; }
        hipOccupancyMaxActiveBlocksPerMultiprocessor(&per_cu, (const void*)mega, 512, LDS_BYTES);
        if (per_cu < 1) { fprintf(stderr, "kernel_launch: occupancy query says %d blocks per CU\n", per_cu); per_cu = 1; }
        grid_blocks = cus * 1;
    }
    if (grid_blocks < 0) return;
    Params p{};
    for (int i = 0; i < 21; ++i) p.in[i] = (const float*)d_in[i];
    p.out = (float*)d_out; p.ws = (unsigned char*)d_ws;
    if (hipMemsetAsync((unsigned char*)d_ws + OFF_BAR, 0, 16384, stream) != hipSuccess) { fprintf(stderr, "kernel_launch: memset of the barrier words failed\n"); return; }
    void* args[] = {&p};
    hipError_t e = hipLaunchCooperativeKernel((const void*)mega, dim3(grid_blocks), dim3(512), args, LDS_BYTES, stream);
    if (e != hipSuccess) fprintf(stderr, "cooperative launch failed: %s (grid %d)\n", hipGetErrorString(e), grid_blocks);
}
```
